# Optimizing an MI355X kernel written in HIP

```python
import math
import jax, jax.numpy as jnp
from jax import lax
import numpy as np

D_MODEL = 1024
BATCH = 4
SEQ = 4096
DEPTH = 1

N_META = 16
BLOCK_Q = 128
RMS_EPS = 1e-6

MLA_HEADS = 16
MLA_Q_RANK = 256
MLA_KV_RANK = 128
MLA_NOPE_DIM = 64
MLA_ROPE_DIM = 32
MLA_V_DIM = 64
MLA_WIDTH = MLA_HEADS * MLA_V_DIM
MLA_SCALE = 1.0 / math.sqrt(MLA_NOPE_DIM + MLA_ROPE_DIM)
ROPE_THETA = 10000.0

FOX_HEADS = 16
FOX_HEAD_DIM = 64
FOX_WIDTH = FOX_HEADS * FOX_HEAD_DIM
FOX_SCALE = 1.0 / math.sqrt(FOX_HEAD_DIM)

IN_SPLITS = (MLA_Q_RANK, MLA_KV_RANK, MLA_ROPE_DIM, MLA_WIDTH,
             FOX_WIDTH, FOX_WIDTH, FOX_WIDTH, FOX_HEADS, FOX_WIDTH,
             D_MODEL, D_MODEL)
IN_WIDTH = sum(IN_SPLITS)

kernel_name = 'hybrid_mla_fox_gated_merge'


def rmsnorm(x, g):
    xf = x.astype(jnp.float32)
    y = xf * lax.rsqrt(jnp.mean(xf * xf, axis=-1, keepdims=True) + RMS_EPS)
    return (y * g.astype(jnp.float32)).astype(x.dtype)


def rope(x, pos):
    half = x.shape[-1] // 2
    inv_freq = ROPE_THETA ** (-jnp.arange(half, dtype=jnp.float32) / half)
    ang = pos.astype(jnp.float32)[:, None] * inv_freq[None, :]
    cos, sin = jnp.cos(ang), jnp.sin(ang)
    x1 = x[..., :half].astype(jnp.float32)
    x2 = x[..., half:].astype(jnp.float32)
    return jnp.concatenate([x1 * cos - x2 * sin, x1 * sin + x2 * cos], axis=-1).astype(x.dtype)


def causal_block_attention(q, k, v, scale, cum=None):
    B, H, L, _ = q.shape
    n_real = L - N_META
    nb = n_real // BLOCK_Q
    key_pos = jnp.arange(L)

    def attend(qb, qpos, cq=None):
        s = jnp.einsum('bhqd,bhkd->bhqk', qb, k, preferred_element_type=jnp.float32) * scale
        if cq is not None:
            s = s + (cq[..., :, None] - cum[:, :, None, :])
        s = jnp.where(key_pos[None, :] <= qpos[:, None], s, -jnp.inf)
        p = jax.nn.softmax(s, axis=-1)
        return jnp.einsum('bhqk,bhkd->bhqd', p.astype(v.dtype), v)

    out_meta = attend(q[:, :, :N_META], key_pos[:N_META],
                      None if cum is None else cum[:, :, :N_META])

    def to_blocks(a):
        a = a[:, :, N_META:]
        a = a.reshape((B, H, nb, BLOCK_Q) + a.shape[3:])
        return jnp.moveaxis(a, 2, 0)

    xs = (to_blocks(q), key_pos[N_META:].reshape(nb, BLOCK_Q))
    if cum is not None:
        xs = xs + (to_blocks(cum),)
    out_real = lax.map(lambda args: attend(*args), xs)
    out_real = jnp.moveaxis(out_real, 0, 2).reshape(B, H, n_real, v.shape[-1])
    return jnp.concatenate([out_meta, out_real], axis=2)


def setup_inputs(seed: int = 0) -> dict:
    key = jax.random.key(seed)
    ks = jax.random.split(key, 13)
    f32 = jnp.float32

    def gain(k, n):
        return 1.0 + 0.1 * jax.random.normal(k, (DEPTH, n), f32)

    def dense(k, fan_in, fan_out):
        return jax.random.normal(k, (DEPTH, fan_in, fan_out), f32) * fan_in ** -0.5

    return {
        'x': jax.random.normal(ks[0], (BATCH, SEQ, D_MODEL), f32),
        'meta_tokens': jax.random.normal(ks[1], (N_META, D_MODEL), f32),
        'pre_norm_g': gain(ks[2], D_MODEL),
        'w_in': dense(ks[3], D_MODEL, IN_WIDTH),
        'fox_forget_b': jax.random.uniform(ks[4], (DEPTH, FOX_HEADS), f32, 1.0, 4.0),
        'mla_q_norm_g': gain(ks[5], MLA_Q_RANK),
        'mla_kv_norm_g': gain(ks[6], MLA_KV_RANK),
        'w_uq': dense(ks[7], MLA_Q_RANK, MLA_HEADS * (MLA_NOPE_DIM + MLA_ROPE_DIM)),
        'w_ukv': dense(ks[8], MLA_KV_RANK, MLA_HEADS * (MLA_NOPE_DIM + MLA_V_DIM)),
        'w_br_mla': dense(ks[9], MLA_WIDTH, D_MODEL),
        'w_br_fox': dense(ks[10], FOX_WIDTH, D_MODEL),
        'w_out': dense(ks[11], D_MODEL, D_MODEL),
        'post_norm_g': gain(ks[12], D_MODEL),
    }


def reference(x, meta_tokens, pre_norm_g, w_in, fox_forget_b, mla_q_norm_g, mla_kv_norm_g,
              w_uq, w_ukv, w_br_mla, w_br_fox, w_out, post_norm_g):
    B, S, D = x.shape
    L = S + N_META
    pos = jnp.arange(L)
    h = jnp.concatenate([jnp.broadcast_to(meta_tokens[None].astype(x.dtype), (B, N_META, D)), x], axis=1)
    split_idx = np.cumsum(IN_SPLITS)[:-1].tolist()

    def fox_heads(t):
        return t.reshape(B, L, FOX_HEADS, FOX_HEAD_DIM).transpose(0, 2, 1, 3)

    for l in range(DEPTH):
        u = rmsnorm(h, pre_norm_g[l])
        proj = u @ w_in[l]
        (cq, ckv, k_pe_raw, z_mla, fq, fk, fv, f_logit, z_fox, gate_a, gate_b) = jnp.split(proj, split_idx, axis=-1)

        q = (rmsnorm(cq, mla_q_norm_g[l]) @ w_uq[l]).reshape(B, L, MLA_HEADS, MLA_NOPE_DIM + MLA_ROPE_DIM).transpose(0, 2, 1, 3)
        kv = (rmsnorm(ckv, mla_kv_norm_g[l]) @ w_ukv[l]).reshape(B, L, MLA_HEADS, MLA_NOPE_DIM + MLA_V_DIM).transpose(0, 2, 1, 3)
        q_nope, q_pe = q[..., :MLA_NOPE_DIM], q[..., MLA_NOPE_DIM:]
        k_nope, v_mla = kv[..., :MLA_NOPE_DIM], kv[..., MLA_NOPE_DIM:]
        k_pe = rope(k_pe_raw, pos)[:, None]
        q_m = jnp.concatenate([q_nope, rope(q_pe, pos)], axis=-1)
        k_m = jnp.concatenate([k_nope, jnp.broadcast_to(k_pe, (B, MLA_HEADS, L, MLA_ROPE_DIM))], axis=-1)
        o_mla = causal_block_attention(q_m, k_m, v_mla, MLA_SCALE)
        o_mla = o_mla.transpose(0, 2, 1, 3).reshape(B, L, MLA_WIDTH)
        y_mla = (o_mla * jax.nn.silu(z_mla)) @ w_br_mla[l]

        log_f = jax.nn.log_sigmoid((f_logit + fox_forget_b[l]).astype(jnp.float32)).transpose(0, 2, 1)
        cum = jnp.cumsum(log_f, axis=-1)
        o_fox = causal_block_attention(fox_heads(fq), fox_heads(fk), fox_heads(fv), FOX_SCALE, cum)
        o_fox = o_fox.transpose(0, 2, 1, 3).reshape(B, L, FOX_WIDTH)
        y_fox = (o_fox * jax.nn.silu(z_fox)) @ w_br_fox[l]

        mixed = (jax.nn.sigmoid(gate_a) * y_mla + jax.nn.sigmoid(gate_b) * y_fox) @ w_out[l]
        h = h + rmsnorm(mixed, post_norm_g[l])

    return h[:, N_META:]
```

```cpp
#include <hip/hip_runtime.h>
#include <hip/hip_cooperative_groups.h>
#include <cstdio>
#include <cstdint>
namespace cg = cooperative_groups;

#ifndef MK_LAUNCHES
#define MK_LAUNCHES 1
#endif
#ifndef PROBE_DUP
#define PROBE_DUP 0
#endif
#ifndef PROBE_MODE
#define PROBE_MODE 0
#endif

typedef unsigned short bf16_t;
typedef short bf16x8 __attribute__((ext_vector_type(8)));
typedef short s16x4 __attribute__((ext_vector_type(4)));
typedef float f32x16 __attribute__((ext_vector_type(16)));
typedef float f32x4 __attribute__((ext_vector_type(4)));
typedef float f32x2 __attribute__((ext_vector_type(2)));
typedef unsigned u32x4 __attribute__((ext_vector_type(4)));
typedef unsigned u32x2 __attribute__((ext_vector_type(2)));
typedef __bf16 bf2_t __attribute__((ext_vector_type(2)));

#define DI __device__ __forceinline__

constexpr int NT = 512;
constexpr int D = 1024, NB = 4, S = 4096, NMETA = 16, L = S + NMETA, T = NB * L;
constexpr int TP = 16640, LP = 4160, NH = 16;
constexpr float EPS = 1e-6f;
constexpr float LOG2E = 1.4426950408889634f;
constexpr float MLA_QS = (float)(1.4426950408889634 / 9.797958971132712);
constexpr float FOX_QS = (float)(1.4426950408889634 / 8.0);

constexpr size_t al256(size_t x) { return (x + 255) & ~(size_t)255; }
constexpr size_t OFF_CTRL = 0;
constexpr size_t OFF_BAR = 4096;
constexpr size_t OFF_SSQ = OFF_BAR + 16384;
constexpr size_t OFF_RSTD0 = OFF_SSQ + (size_t)NB * S * 4;
constexpr size_t OFF_ROPE = OFF_RSTD0 + al256((size_t)TP * 4);
constexpr size_t OFF_BIAS = OFF_ROPE + al256((size_t)LP * 32 * 4);
constexpr size_t OFF_FLOGIT = OFF_BIAS + al256((size_t)NB * NH * LP * 4);
constexpr size_t OFF_SSQC = OFF_FLOGIT + al256((size_t)TP * 16 * 4);
constexpr size_t OFF_RKV = OFF_SSQC + al256((size_t)TP * 4);
constexpr size_t OFF_WT1 = OFF_RKV + al256((size_t)TP * 4);
constexpr size_t OFF_WZ = OFF_WT1 + (size_t)3584 * 1024 * 2;
constexpr size_t OFF_WG = OFF_WZ + (size_t)2048 * 1024 * 2;
constexpr size_t OFF_WUQ = OFF_WG + (size_t)2048 * 1024 * 2;
constexpr size_t OFF_WUKV = OFF_WUQ + (size_t)1536 * 256 * 2;
constexpr size_t OFF_WBM = OFF_WUKV + (size_t)2048 * 128 * 2;
constexpr size_t OFF_WBF = OFF_WBM + (size_t)1024 * 1024 * 2;
constexpr size_t OFF_WOUT = OFF_WBF + (size_t)1024 * 1024 * 2;
constexpr size_t OFF_HB = OFF_WOUT + (size_t)1024 * 1024 * 2;
constexpr size_t OFF_FQ = OFF_HB + (size_t)TP * 1024 * 2;
constexpr size_t OFF_FK = OFF_FQ + (size_t)TP * 1024 * 2;
constexpr size_t OFF_QN = OFF_FK + (size_t)TP * 1024 * 2;
constexpr size_t OFF_QPE = OFF_QN + (size_t)TP * 1024 * 2;
constexpr size_t OFF_FVT = OFF_QPE + (size_t)TP * 512 * 2;
constexpr size_t OFF_VMT = OFF_FVT + (size_t)NB * NH * 64 * LP * 2;
constexpr size_t WS_END = OFF_VMT + (size_t)NB * NH * 64 * LP * 2;
static_assert(WS_END <= ((size_t)256 << 20), "workspace too large");
constexpr size_t OUT_KM = 0;
constexpr size_t OUT_CQ = OUT_KM + (size_t)TP * 1536 * 2;
constexpr size_t OUT_CKV = OUT_CQ + (size_t)TP * 256 * 2;
constexpr size_t OUT_KPE = OUT_CKV + (size_t)TP * 128 * 2;
static_assert(OUT_KPE + (size_t)TP * 32 * 4 <= (size_t)NB * S * D * 4, "d_out scratch too large");

struct Params {
    const float *x, *meta, *pre_g, *w_in, *fox_b, *qn_g, *kvn_g, *w_uq, *w_ukv, *w_bm, *w_bf, *w_out, *post_g;
    float* out;
    unsigned char* ws;
};

DI unsigned pk2(float lo, float hi) { f32x2 v = {lo, hi}; bf2_t b = __builtin_convertvector(v, bf2_t); return __builtin_bit_cast(unsigned, b); }
DI u32x2 pk4(float a, float b, float c, float d) { u32x2 r; r.x = pk2(a, b); r.y = pk2(c, d); return r; }
DI float bf_lo(unsigned u) { return __uint_as_float(u << 16); }
DI float bf_hi(unsigned u) { return __uint_as_float(u & 0xffff0000u); }
DI float fsigmoid(float z) { return __builtin_amdgcn_rcpf(1.0f + __expf(-z)); }
DI float fsilu(float z) { return z * fsigmoid(z); }
DI int crow(int r, int h) { return (r & 3) + 8 * (r >> 2) + 4 * h; }

#define XB_TMO      128
#define XB_XCNT(j)  (256  + 64 * (j))
#define XB_XSUB(j)  (1280 + 64 * (j))
#define XB_XGEN(j)  (2304 + 64 * (j))
#define XB_TOP      3328
#define XB_TOPGEN   3392
#define XCD_BAR_WORDS 3456
#define XB_SPIN_CAP (1u << 18)
#define LAS __attribute__((address_space(3)))
DI unsigned xb_ld(unsigned* p) { return __hip_atomic_load(p, __ATOMIC_RELAXED, __HIP_MEMORY_SCOPE_AGENT); }
DI unsigned xb_add(unsigned* p, unsigned v) { return __hip_atomic_fetch_add(p, v, __ATOMIC_RELAXED, __HIP_MEMORY_SCOPE_AGENT); }
DI unsigned xb_xcc_id() { return (unsigned)__builtin_amdgcn_s_getreg((3 << 11) | 20) & 0xFu; }
#define XB_SPIN(cond, bar) do { unsigned _sp = 0; while (cond) { __builtin_amdgcn_s_sleep(1); \
    if ((++_sp & 255u) == 0u) { if (xb_ld(&(bar)[XB_TMO])) break; if (_sp > XB_SPIN_CAP) { atomicAdd(&(bar)[XB_TMO], 1u); break; } } } } while (0)
struct XcdBarrier { unsigned* bar; unsigned x; volatile LAS unsigned* st; };
DI XcdBarrier xcd_barrier_post(unsigned* bar, volatile LAS unsigned* st) {
    XcdBarrier b; b.bar = bar; b.x = xb_xcc_id(); b.st = st;
    if (threadIdx.x == 0) (void)xb_add(&bar[XB_XCNT(b.x)], 1u);
    return b;
}
DI void xcd_barrier_complete(unsigned* bar, unsigned x, unsigned& nloc, unsigned& nx) {
    const unsigned G = gridDim.x * gridDim.y * gridDim.z;
    unsigned sum, cnt, mine, sp = 0u;
    for (;;) {
        sum = 0u; cnt = 0u; mine = 0u;
#pragma unroll
        for (unsigned j = 0; j < 16; ++j) { const unsigned c = xb_ld(&bar[XB_XCNT(j)]); sum += c; cnt += (c > 0u) ? 1u : 0u; mine = (j == x) ? c : mine; }
        if (sum == G) break;
        __builtin_amdgcn_s_sleep(1);
        if ((++sp & 255u) == 0u) { if (xb_ld(&bar[XB_TMO])) break; if (sp > XB_SPIN_CAP) { atomicAdd(&bar[XB_TMO], 1u); break; } }
    }
    nloc = mine > 0u ? mine : 1u; nx = cnt > 0u ? cnt : 1u;
}
DI void xcd_barrier(const XcdBarrier& b) {
    asm volatile("s_waitcnt vmcnt(0)" ::: "memory");
    __syncthreads();
    if (threadIdx.x == 0) {
        unsigned* bar = b.bar;
        __builtin_amdgcn_s_waitcnt(0);
        unsigned nloc = b.st[0], nx = b.st[1];
        if (nloc == 0u) { xcd_barrier_complete(bar, b.x, nloc, nx); b.st[0] = nloc; b.st[1] = nx; }
        const unsigned old = xb_add(&bar[XB_XSUB(b.x)], 1u);
        const unsigned gen = old / nloc;
        if (old + 1u == (gen + 1u) * nloc) {
            __builtin_amdgcn_fence(__ATOMIC_RELEASE, "agent");
            asm volatile("s_waitcnt vmcnt(0)" ::: "memory");
            const unsigned og = xb_add(&bar[XB_TOP], 1u);
            const unsigned tg = og / nx;
            if (og + 1u == (tg + 1u) * nx) xb_add(&bar[XB_TOPGEN], 1u);
            else XB_SPIN(xb_ld(&bar[XB_TOPGEN]) == tg, bar);
            __builtin_amdgcn_fence(__ATOMIC_ACQUIRE, "agent");
            xb_add(&bar[XB_XGEN(b.x)], 1u);
            asm volatile("s_waitcnt vmcnt(0)" ::: "memory");
        } else {
            XB_SPIN(xb_ld(&bar[XB_XGEN(b.x)]) == gen, bar);
            __builtin_amdgcn_fence(__ATOMIC_ACQUIRE, "agent");
            asm volatile("s_waitcnt vmcnt(0)" ::: "memory");
        }
    }
    __syncthreads();
}

constexpr int BK = 32, LROW = 80;
constexpr int LDS_MISC = 2048;
template <int WI, int WGJ> struct GC {
    static constexpr int WGI = 8 / WGJ, BI = WGI * WI * 32, BJ = WGJ * 64, STAGE = (BI + BJ) * LROW, NP = BI * 4 / NT, NQ = BJ * 4 / NT;
};
constexpr int LDS_BYTES = LDS_MISC + 3 * GC<4, 4>::STAGE;

template <int WI, int WGJ, int MODE = 0>
DI void gemm_tile2(const bf16_t* __restrict__ P, int ldp, const bf16_t* __restrict__ Q, int ldq, int K,
                  unsigned char* lds, f32x16 (&acc)[WI][2], int tid) {
    typedef GC<WI, WGJ> C;
    constexpr int NP = C::NP, NQ = C::NQ, STAGE = C::STAGE, BI = C::BI;
    const int lane = tid & 63, wid = tid >> 6, wi = wid / WGJ, wj = wid % WGJ;
    const int lrow = tid >> 2, lch = tid & 3;
    const bf16_t* pp = P + (size_t)lrow * ldp + lch * 8;
    const bf16_t* qp = Q + (size_t)lrow * ldq + lch * 8;
    unsigned char* wP = lds + lrow * LROW + lch * 16;
    const unsigned char* rP = lds + (wi * WI * 32 + (lane & 31)) * LROW + (lane >> 5) * 16;
    const unsigned char* rQ = lds + BI * LROW + (wj * 64 + (lane & 31)) * LROW + (lane >> 5) * 16;
    u32x4 pa[NP], qa[NQ], pb[NP], qb[NQ];
    bf16x8 fa0[WI], fb0[2], fa1[WI], fb1[2];
#pragma unroll
    for (int it = 0; it < WI; ++it)
#pragma unroll
        for (int jt = 0; jt < 2; ++jt)
#pragma unroll
            for (int r = 0; r < 16; ++r) acc[it][jt][r] = 0.f;
    const int nk = K / BK;
#define G_LOAD(pr, qr, kt_) if (MODE != 1) { _Pragma("unroll") for (int r = 0; r < NP; ++r) pr[r] = *(const u32x4*)(pp + (size_t)(r * 128) * ldp + (kt_) * BK); \
                              _Pragma("unroll") for (int r = 0; r < NQ; ++r) qr[r] = *(const u32x4*)(qp + (size_t)(r * 128) * ldq + (kt_) * BK); }
#define G_STORE(pr, qr, so_) { unsigned char* w_ = wP + (so_); \
                              _Pragma("unroll") for (int r = 0; r < NP; ++r) *(u32x4*)(w_ + r * 128 * LROW) = pr[r]; \
                              _Pragma("unroll") for (int r = 0; r < NQ; ++r) *(u32x4*)(w_ + BI * LROW + r * 128 * LROW) = qr[r]; }
#define F_LOAD(fa, fb, so_, ks_) { _Pragma("unroll") for (int it = 0; it < WI; ++it) fa[it] = *(const bf16x8*)(rP + (so_) + it * 32 * LROW + (ks_) * 32); \
                                  _Pragma("unroll") for (int jt = 0; jt < 2; ++jt) fb[jt] = *(const bf16x8*)(rQ + (so_) + jt * 32 * LROW + (ks_) * 32); }
#define G_MFMA(fa, fb) if (MODE != 2) { _Pragma("unroll") for (int it = 0; it < WI; ++it) _Pragma("unroll") for (int jt = 0; jt < 2; ++jt) \
                            acc[it][jt] = __builtin_amdgcn_mfma_f32_32x32x16_bf16(fa[it], fb[jt], acc[it][jt], 0, 0, 0); }
#define SB __builtin_amdgcn_sched_barrier(0);
    if (MODE == 1) {
#pragma unroll
        for (int r = 0; r < NP; ++r) { pa[r] = *(const u32x4*)(pp + (size_t)(r * 128) * ldp); pb[r] = pa[r]; }
#pragma unroll
        for (int r = 0; r < NQ; ++r) { qa[r] = *(const u32x4*)(qp + (size_t)(r * 128) * ldq); qb[r] = qa[r]; }
    }
    G_LOAD(pa, qa, 0)
    G_LOAD(pb, qb, 1)
    G_STORE(pa, qa, 0)
    G_LOAD(pa, qa, 2)
    G_STORE(pb, qb, STAGE)
    __syncthreads();
    F_LOAD(fa0, fb0, 0, 0)
    int cur = 0, nxt = STAGE, wr = 2 * STAGE;
#pragma unroll 1
    for (int kt = 0; kt < nk; kt += 2) {
        const int k3 = min(kt + 3, nk - 1), k4 = min(kt + 4, nk - 1);
        SB
        G_LOAD(pb, qb, k3)
        F_LOAD(fa1, fb1, cur, 1)
        SB
        G_MFMA(fa0, fb0)
        SB
        G_STORE(pa, qa, wr)
        F_LOAD(fa0, fb0, nxt, 0)
        SB
        G_MFMA(fa1, fb1)
        SB
        __syncthreads();
        { const int t_ = cur; cur = nxt; nxt = wr; wr = t_; }
        SB
        G_LOAD(pa, qa, k4)
        F_LOAD(fa1, fb1, cur, 1)
        SB
        G_MFMA(fa0, fb0)
        SB
        G_STORE(pb, qb, wr)
        F_LOAD(fa0, fb0, nxt, 0)
        SB
        G_MFMA(fa1, fb1)
        SB
        __syncthreads();
        { const int t_ = cur; cur = nxt; nxt = wr; wr = t_; }
    }
#undef G_LOAD
#undef G_STORE
#undef F_LOAD
#undef G_MFMA
#undef SB
}

template <int WI, int WGJ, int MODE = 0>
DI void gemm_tile3(const bf16_t* __restrict__ P, int ldp, const bf16_t* __restrict__ Q, int ldq, int K,
                  unsigned char* lds, f32x16 (&acc)[WI][2], int tid) {
    typedef GC<WI, WGJ> C;
    constexpr int NP = C::NP, NQ = C::NQ, STAGE = C::STAGE, BI = C::BI;
    const int lane = tid & 63, wid = tid >> 6, wi = wid / WGJ, wj = wid % WGJ;
    const int lrow = tid >> 2, lch = tid & 3;
    const bf16_t* pp = P + (size_t)lrow * ldp + lch * 8;
    const bf16_t* qp = Q + (size_t)lrow * ldq + lch * 8;
    unsigned char* wP = lds + lrow * LROW + lch * 16;
    const unsigned char* rP = lds + (wi * WI * 32 + (lane & 31)) * LROW + (lane >> 5) * 16;
    const unsigned char* rQ = lds + BI * LROW + (wj * 64 + (lane & 31)) * LROW + (lane >> 5) * 16;
    u32x4 p0[NP], q0[NQ], p1[NP], q1[NQ], p2[NP], q2[NQ];
    bf16x8 fa0[WI], fb0[2], fa1[WI], fb1[2];
#pragma unroll
    for (int it = 0; it < WI; ++it)
#pragma unroll
        for (int jt = 0; jt < 2; ++jt)
#pragma unroll
            for (int r = 0; r < 16; ++r) acc[it][jt][r] = 0.f;
    const int nk = K / BK;
#define G_LOAD(pr, qr, kt_) if (MODE != 1) { _Pragma("unroll") for (int r = 0; r < NP; ++r) pr[r] = *(const u32x4*)(pp + (size_t)(r * 128) * ldp + (kt_) * BK); \
                              _Pragma("unroll") for (int r = 0; r < NQ; ++r) qr[r] = *(const u32x4*)(qp + (size_t)(r * 128) * ldq + (kt_) * BK); }
#define G_STORE(pr, qr, so_) { unsigned char* w_ = wP + (so_); \
                              _Pragma("unroll") for (int r = 0; r < NP; ++r) *(u32x4*)(w_ + r * 128 * LROW) = pr[r]; \
                              _Pragma("unroll") for (int r = 0; r < NQ; ++r) *(u32x4*)(w_ + BI * LROW + r * 128 * LROW) = qr[r]; }
#define F_LOAD(fa, fb, so_, ks_) { _Pragma("unroll") for (int it = 0; it < WI; ++it) fa[it] = *(const bf16x8*)(rP + (so_) + it * 32 * LROW + (ks_) * 32); \
                                  _Pragma("unroll") for (int jt = 0; jt < 2; ++jt) fb[jt] = *(const bf16x8*)(rQ + (so_) + jt * 32 * LROW + (ks_) * 32); }
#define G_MFMA(fa, fb) if (MODE != 2) { _Pragma("unroll") for (int it = 0; it < WI; ++it) _Pragma("unroll") for (int jt = 0; jt < 2; ++jt) \
                            acc[it][jt] = __builtin_amdgcn_mfma_f32_32x32x16_bf16(fa[it], fb[jt], acc[it][jt], 0, 0, 0); }
#define SB __builtin_amdgcn_sched_barrier(0);
#define G_HALF(pl, ql, ps, qs, kt_) { const int k4_ = min((kt_) + 4, nk - 1); \
        SB G_LOAD(pl, ql, k4_) F_LOAD(fa1, fb1, cur, 1) SB G_MFMA(fa0, fb0) SB G_STORE(ps, qs, wr) F_LOAD(fa0, fb0, nxt, 0) SB G_MFMA(fa1, fb1) SB \
        __syncthreads(); { const int t_ = cur; cur = nxt; nxt = wr; wr = t_; } }
    if (MODE == 1) {
#pragma unroll
        for (int r = 0; r < NP; ++r) { p0[r] = *(const u32x4*)(pp + (size_t)(r * 128) * ldp); p1[r] = p0[r]; p2[r] = p0[r]; }
#pragma unroll
        for (int r = 0; r < NQ; ++r) { q0[r] = *(const u32x4*)(qp + (size_t)(r * 128) * ldq); q1[r] = q0[r]; q2[r] = q0[r]; }
    }
    G_LOAD(p0, q0, 0)
    G_LOAD(p1, q1, 1)
    G_LOAD(p2, q2, 2)
    G_STORE(p0, q0, 0)
    G_LOAD(p0, q0, 3)
    G_STORE(p1, q1, STAGE)
    __syncthreads();
    F_LOAD(fa0, fb0, 0, 0)
    int cur = 0, nxt = STAGE, wr = 2 * STAGE;
    int kt = 0;
#pragma unroll 1
    for (; kt + 3 <= nk; kt += 3) {
        G_HALF(p1, q1, p2, q2, kt)
        G_HALF(p2, q2, p0, q0, kt + 1)
        G_HALF(p0, q0, p1, q1, kt + 2)
    }
    if (kt < nk) G_HALF(p1, q1, p2, q2, kt)
    if (kt + 1 < nk) G_HALF(p2, q2, p0, q0, kt + 1)
#undef G_HALF
#undef G_LOAD
#undef G_STORE
#undef F_LOAD
#undef G_MFMA
#undef SB
}

template <int WI, int WGJ, int MODE = 0, bool ZERO = true>
DI void gemm_tile3r(const bf16_t* __restrict__ P, int ldp, const bf16_t* __restrict__ Q, int ldq, int K,
                  unsigned char* lds, f32x16 (&acc)[WI][2], int tid) {
    typedef GC<WI, WGJ> C;
    constexpr int NP = C::NP, NQ = C::NQ, STAGE = C::STAGE, BI = C::BI;
    const int lane = tid & 63, wid = tid >> 6, wi = wid / WGJ, wj = wid % WGJ;
    const int lrow = tid >> 2, lch = tid & 3;
    const bf16_t* pp = P + (size_t)lrow * ldp + lch * 8;
    const bf16_t* qp = Q + (size_t)lrow * ldq + lch * 8;
    unsigned char* wP = lds + lrow * LROW + lch * 16;
    const unsigned char* rP = lds + (wi * WI * 32 + (lane & 31)) * LROW + (lane >> 5) * 16;
    const unsigned char* rQ = lds + BI * LROW + (wj * 64 + (lane & 31)) * LROW + (lane >> 5) * 16;
    u32x4 p0[NP], q0[NQ], p1[NP], q1[NQ], p2[NP], q2[NQ];
    bf16x8 fa0[WI], fb0[2], fb1[2];
    if (ZERO) {
#pragma unroll
        for (int it = 0; it < WI; ++it)
#pragma unroll
            for (int jt = 0; jt < 2; ++jt)
#pragma unroll
                for (int r = 0; r < 16; ++r) acc[it][jt][r] = 0.f;
    }
    const int nk = K / BK;
#define G_LOAD(pr, qr, kt_) if (MODE != 1) { _Pragma("unroll") for (int r = 0; r < NP; ++r) pr[r] = *(const u32x4*)(pp + (size_t)(r * 128) * ldp + (kt_) * BK); \
                              _Pragma("unroll") for (int r = 0; r < NQ; ++r) qr[r] = *(const u32x4*)(qp + (size_t)(r * 128) * ldq + (kt_) * BK); }
#define G_STORE(pr, qr, so_) { unsigned char* w_ = wP + (so_); \
                              _Pragma("unroll") for (int r = 0; r < NP; ++r) *(u32x4*)(w_ + r * 128 * LROW) = pr[r]; \
                              _Pragma("unroll") for (int r = 0; r < NQ; ++r) *(u32x4*)(w_ + BI * LROW + r * 128 * LROW) = qr[r]; }
#define F_LOAD(fa, fb, so_, ks_) { _Pragma("unroll") for (int it = 0; it < WI; ++it) fa[it] = *(const bf16x8*)(rP + (so_) + it * 32 * LROW + (ks_) * 32); \
                                  _Pragma("unroll") for (int jt = 0; jt < 2; ++jt) fb[jt] = *(const bf16x8*)(rQ + (so_) + jt * 32 * LROW + (ks_) * 32); }
#define G_MFMA(fa, fb) if (MODE != 2) { _Pragma("unroll") for (int it = 0; it < WI; ++it) _Pragma("unroll") for (int jt = 0; jt < 2; ++jt) \
                            acc[it][jt] = __builtin_amdgcn_mfma_f32_32x32x16_bf16(fa[it], fb[jt], acc[it][jt], 0, 0, 0); }
#define SB __builtin_amdgcn_sched_barrier(0);
#define A_LD(it_, so_, ks_) fa0[it_] = *(const bf16x8*)(rP + (so_) + (it_) * 32 * LROW + (ks_) * 32);
#define B_LD(fb, so_, ks_) { _Pragma("unroll") for (int jt = 0; jt < 2; ++jt) fb[jt] = *(const bf16x8*)(rQ + (so_) + jt * 32 * LROW + (ks_) * 32); }
#define X_LOAD(it_, pl, ql, kt_) if (MODE != 1) { if ((it_) < NP) pl[(it_) < NP ? (it_) : 0] = *(const u32x4*)(pp + (size_t)(((it_) < NP ? (it_) : 0) * 128) * ldp + (kt_) * BK); \
                                  else ql[(it_) >= NP ? (it_) - NP : 0] = *(const u32x4*)(qp + (size_t)(((it_) >= NP ? (it_) - NP : 0) * 128) * ldq + (kt_) * BK); }
#define X_STORE(it_, ps, qs, so_) { if ((it_) < NP) *(u32x4*)(wP + (so_) + ((it_) < NP ? (it_) : 0) * 128 * LROW) = ps[(it_) < NP ? (it_) : 0]; \
                                   else *(u32x4*)(wP + (so_) + BI * LROW + ((it_) >= NP ? (it_) - NP : 0) * 128 * LROW) = qs[(it_) >= NP ? (it_) - NP : 0]; }
#define B_LD1(fbn, jt_, so_, ks_) fbn[jt_] = *(const bf16x8*)(rQ + (so_) + (jt_) * 32 * LROW + (ks_) * 32);
#define R_BURST1(fb, fbn, so_, ks_, pl, ql, kt_, ps, qs, wo_) { _Pragma("unroll") for (int it = 0; it < WI; ++it) { \
            acc[it][0] = __builtin_amdgcn_mfma_f32_32x32x16_bf16(fa0[it], fb[0], acc[it][0], 0, 0, 0); SB \
            if (it < 2) B_LD1(fbn, it < 2 ? it : 0, so_, ks_) X_STORE(it, ps, qs, wo_) SB \
            acc[it][1] = __builtin_amdgcn_mfma_f32_32x32x16_bf16(fa0[it], fb[1], acc[it][1], 0, 0, 0); SB A_LD(it, so_, ks_) X_LOAD(it, pl, ql, kt_) SB } }
#define R_BURST2(fb, fbn, so_, ks_, ps, qs, wo_) { _Pragma("unroll") for (int it = 0; it < WI; ++it) { \
            acc[it][0] = __builtin_amdgcn_mfma_f32_32x32x16_bf16(fa0[it], fb[0], acc[it][0], 0, 0, 0); SB \
            if (it < 2) B_LD1(fbn, it < 2 ? it : 0, so_, ks_) SB \
            acc[it][1] = __builtin_amdgcn_mfma_f32_32x32x16_bf16(fa0[it], fb[1], acc[it][1], 0, 0, 0); SB A_LD(it, so_, ks_) SB } }
#define G_HALF(pl, ql, ps, qs, kt_) { const int k4_ = min((kt_) + 4, nk - 1); \
        SB R_BURST1(fb0, fb1, cur, 1, pl, ql, k4_, ps, qs, wr) R_BURST2(fb1, fb0, nxt, 0, ps, qs, wr) \
        asm volatile("s_waitcnt lgkmcnt(6)\n\ts_barrier" ::: "memory"); { const int t_ = cur; cur = nxt; nxt = wr; wr = t_; } }
    if (MODE == 1) {
#pragma unroll
        for (int r = 0; r < NP; ++r) { p0[r] = *(const u32x4*)(pp + (size_t)(r * 128) * ldp); p1[r] = p0[r]; p2[r] = p0[r]; }
#pragma unroll
        for (int r = 0; r < NQ; ++r) { q0[r] = *(const u32x4*)(qp + (size_t)(r * 128) * ldq); q1[r] = q0[r]; q2[r] = q0[r]; }
    }
    G_LOAD(p0, q0, 0)
    G_LOAD(p1, q1, 1)
    G_LOAD(p2, q2, 2)
    G_STORE(p0, q0, 0)
    G_LOAD(p0, q0, 3)
    G_STORE(p1, q1, STAGE)
    __syncthreads();
    F_LOAD(fa0, fb0, 0, 0)
    int cur = 0, nxt = STAGE, wr = 2 * STAGE;
    int kt = 0;
#pragma unroll 1
    for (; kt + 3 <= nk; kt += 3) {
        G_HALF(p1, q1, p2, q2, kt)
        G_HALF(p2, q2, p0, q0, kt + 1)
        G_HALF(p0, q0, p1, q1, kt + 2)
    }
    if (kt < nk) G_HALF(p1, q1, p2, q2, kt)
    if (kt + 1 < nk) G_HALF(p2, q2, p0, q0, kt + 1)
#undef G_HALF
#undef A_LD
#undef B_LD
#undef B_LD1
#undef R_BURST1
#undef R_BURST2
#undef X_LOAD
#undef X_STORE
#undef G_LOAD
#undef G_STORE
#undef F_LOAD
#undef G_MFMA
#undef SB
}
struct GSets { u32x4 p0[2], q0[2], p1[2], q1[2], p2[2], q2[2]; };
DI void gemm_issue(const bf16_t* __restrict__ P, const bf16_t* __restrict__ Q, GSets& g, int tid) {
    const bf16_t* pp = P + (size_t)(tid >> 2) * 1024 + (tid & 3) * 8;
    const bf16_t* qp = Q + (size_t)(tid >> 2) * 1024 + (tid & 3) * 8;
#pragma unroll
    for (int r = 0; r < 2; ++r) { g.p0[r] = *(const u32x4*)(pp + (size_t)(r * 128) * 1024); g.q0[r] = *(const u32x4*)(qp + (size_t)(r * 128) * 1024); }
#pragma unroll
    for (int r = 0; r < 2; ++r) { g.p1[r] = *(const u32x4*)(pp + (size_t)(r * 128) * 1024 + BK); g.q1[r] = *(const u32x4*)(qp + (size_t)(r * 128) * 1024 + BK); }
#pragma unroll
    for (int r = 0; r < 2; ++r) { g.p2[r] = *(const u32x4*)(pp + (size_t)(r * 128) * 1024 + 2 * BK); g.q2[r] = *(const u32x4*)(qp + (size_t)(r * 128) * 1024 + 2 * BK); }
}
template <int WI, int WGJ, int MODE = 0, bool ZERO = true>
DI void gemm_tile3p(const bf16_t* __restrict__ P, int ldp, const bf16_t* __restrict__ Q, int ldq,
                  unsigned char* lds, f32x16 (&acc)[WI][2], int tid, GSets& g) {
    typedef GC<WI, WGJ> C;
    constexpr int NP = C::NP, NQ = C::NQ, STAGE = C::STAGE, BI = C::BI;
    const int lane = tid & 63, wid = tid >> 6, wi = wid / WGJ, wj = wid % WGJ;
    const int lrow = tid >> 2, lch = tid & 3;
    const bf16_t* pp = P + (size_t)lrow * ldp + lch * 8;
    const bf16_t* qp = Q + (size_t)lrow * ldq + lch * 8;
    unsigned char* wP = lds + lrow * LROW + lch * 16;
    const unsigned char* rP = lds + (wi * WI * 32 + (lane & 31)) * LROW + (lane >> 5) * 16;
    const unsigned char* rQ = lds + BI * LROW + (wj * 64 + (lane & 31)) * LROW + (lane >> 5) * 16;
    static_assert(WI == 4 && WGJ == 4, "prefetching core: 256 x 256 tiles only");
    u32x4 (&p0)[2] = g.p0, (&q0)[2] = g.q0, (&p1)[2] = g.p1, (&q1)[2] = g.q1, (&p2)[2] = g.p2, (&q2)[2] = g.q2;
    bf16x8 fa0[WI], fb0[2], fb1[2];
    if (ZERO) {
#pragma unroll
        for (int it = 0; it < WI; ++it)
#pragma unroll
            for (int jt = 0; jt < 2; ++jt)
#pragma unroll
                for (int r = 0; r < 16; ++r) acc[it][jt][r] = 0.f;
    }
    constexpr int nk = 1024 / BK;
#define G_LOAD(pr, qr, kt_) if (MODE != 1) { _Pragma("unroll") for (int r = 0; r < NP; ++r) pr[r] = *(const u32x4*)(pp + (size_t)(r * 128) * ldp + (kt_) * BK); \
                              _Pragma("unroll") for (int r = 0; r < NQ; ++r) qr[r] = *(const u32x4*)(qp + (size_t)(r * 128) * ldq + (kt_) * BK); }
#define G_STORE(pr, qr, so_) { unsigned char* w_ = wP + (so_); \
                              _Pragma("unroll") for (int r = 0; r < NP; ++r) *(u32x4*)(w_ + r * 128 * LROW) = pr[r]; \
                              _Pragma("unroll") for (int r = 0; r < NQ; ++r) *(u32x4*)(w_ + BI * LROW + r * 128 * LROW) = qr[r]; }
#define F_LOAD(fa, fb, so_, ks_) { _Pragma("unroll") for (int it = 0; it < WI; ++it) fa[it] = *(const bf16x8*)(rP + (so_) + it * 32 * LROW + (ks_) * 32); \
                                  _Pragma("unroll") for (int jt = 0; jt < 2; ++jt) fb[jt] = *(const bf16x8*)(rQ + (so_) + jt * 32 * LROW + (ks_) * 32); }
#define G_MFMA(fa, fb) if (MODE != 2) { _Pragma("unroll") for (int it = 0; it < WI; ++it) _Pragma("unroll") for (int jt = 0; jt < 2; ++jt) \
                            acc[it][jt] = __builtin_amdgcn_mfma_f32_32x32x16_bf16(fa[it], fb[jt], acc[it][jt], 0, 0, 0); }
#define SB __builtin_amdgcn_sched_barrier(0);
#define A_LD(it_, so_, ks_) fa0[it_] = *(const bf16x8*)(rP + (so_) + (it_) * 32 * LROW + (ks_) * 32);
#define B_LD(fb, so_, ks_) { _Pragma("unroll") for (int jt = 0; jt < 2; ++jt) fb[jt] = *(const bf16x8*)(rQ + (so_) + jt * 32 * LROW + (ks_) * 32); }
#define X_LOAD(it_, pl, ql, kt_) if (MODE != 1) { if ((it_) < NP) pl[(it_) < NP ? (it_) : 0] = *(const u32x4*)(pp + (size_t)(((it_) < NP ? (it_) : 0) * 128) * ldp + (kt_) * BK); \
                                  else ql[(it_) >= NP ? (it_) - NP : 0] = *(const u32x4*)(qp + (size_t)(((it_) >= NP ? (it_) - NP : 0) * 128) * ldq + (kt_) * BK); }
#define X_STORE(it_, ps, qs, so_) { if ((it_) < NP) *(u32x4*)(wP + (so_) + ((it_) < NP ? (it_) : 0) * 128 * LROW) = ps[(it_) < NP ? (it_) : 0]; \
                                   else *(u32x4*)(wP + (so_) + BI * LROW + ((it_) >= NP ? (it_) - NP : 0) * 128 * LROW) = qs[(it_) >= NP ? (it_) - NP : 0]; }
#define B_LD1(fbn, jt_, so_, ks_) fbn[jt_] = *(const bf16x8*)(rQ + (so_) + (jt_) * 32 * LROW + (ks_) * 32);
#define R_BURST1(fb, fbn, so_, ks_, pl, ql, kt_, ps, qs, wo_) { _Pragma("unroll") for (int it = 0; it < WI; ++it) { \
            acc[it][0] = __builtin_amdgcn_mfma_f32_32x32x16_bf16(fa0[it], fb[0], acc[it][0], 0, 0, 0); SB \
            if (it < 2) B_LD1(fbn, it < 2 ? it : 0, so_, ks_) X_STORE(it, ps, qs, wo_) SB \
            acc[it][1] = __builtin_amdgcn_mfma_f32_32x32x16_bf16(fa0[it], fb[1], acc[it][1], 0, 0, 0); SB A_LD(it, so_, ks_) X_LOAD(it, pl, ql, kt_) SB } }
#define R_BURST2(fb, fbn, so_, ks_, ps, qs, wo_) { _Pragma("unroll") for (int it = 0; it < WI; ++it) { \
            acc[it][0] = __builtin_amdgcn_mfma_f32_32x32x16_bf16(fa0[it], fb[0], acc[it][0], 0, 0, 0); SB \
            if (it < 2) B_LD1(fbn, it < 2 ? it : 0, so_, ks_) SB \
            acc[it][1] = __builtin_amdgcn_mfma_f32_32x32x16_bf16(fa0[it], fb[1], acc[it][1], 0, 0, 0); SB A_LD(it, so_, ks_) SB } }
#define G_HALF(pl, ql, ps, qs, kt_) { const int k4_ = min((kt_) + 4, nk - 1); \
        SB R_BURST1(fb0, fb1, cur, 1, pl, ql, k4_, ps, qs, wr) R_BURST2(fb1, fb0, nxt, 0, ps, qs, wr) \
        asm volatile("s_waitcnt lgkmcnt(6)\n\ts_barrier" ::: "memory"); { const int t_ = cur; cur = nxt; nxt = wr; wr = t_; } }
#define R_BURST1N(fb, fbn, so_, ks_) { _Pragma("unroll") for (int it = 0; it < WI; ++it) { \
            acc[it][0] = __builtin_amdgcn_mfma_f32_32x32x16_bf16(fa0[it], fb[0], acc[it][0], 0, 0, 0); SB \
            if (it < 2) B_LD1(fbn, it < 2 ? it : 0, so_, ks_) SB \
            acc[it][1] = __builtin_amdgcn_mfma_f32_32x32x16_bf16(fa0[it], fb[1], acc[it][1], 0, 0, 0); SB A_LD(it, so_, ks_) SB } }
#define R_BURST1S(fb, fbn, so_, ks_, ps, qs, wo_) { _Pragma("unroll") for (int it = 0; it < WI; ++it) { \
            acc[it][0] = __builtin_amdgcn_mfma_f32_32x32x16_bf16(fa0[it], fb[0], acc[it][0], 0, 0, 0); SB \
            if (it < 2) B_LD1(fbn, it < 2 ? it : 0, so_, ks_) X_STORE(it, ps, qs, wo_) SB \
            acc[it][1] = __builtin_amdgcn_mfma_f32_32x32x16_bf16(fa0[it], fb[1], acc[it][1], 0, 0, 0); SB A_LD(it, so_, ks_) SB } }
#define G_HALF_NL(ps, qs, kt_) { SB R_BURST1S(fb0, fb1, cur, 1, ps, qs, wr) R_BURST2(fb1, fb0, nxt, 0, ps, qs, wr) \
        asm volatile("s_waitcnt lgkmcnt(6)\n\ts_barrier" ::: "memory"); { const int t_ = cur; cur = nxt; nxt = wr; wr = t_; } }
#define G_HALF_NN(kt_) { SB R_BURST1N(fb0, fb1, cur, 1) R_BURST1N(fb1, fb0, nxt, 0) \
        asm volatile("s_waitcnt lgkmcnt(6)\n\ts_barrier" ::: "memory"); { const int t_ = cur; cur = nxt; nxt = wr; wr = t_; } }
    G_STORE(p0, q0, 0)
    G_LOAD(p0, q0, 3)
    G_STORE(p1, q1, STAGE)
    __syncthreads();
    F_LOAD(fa0, fb0, 0, 0)
    int cur = 0, nxt = STAGE, wr = 2 * STAGE;
    int kt = 0;
#pragma unroll 1
    for (; kt + 3 <= nk - 4; kt += 3) {
        G_HALF(p1, q1, p2, q2, kt)
        G_HALF(p2, q2, p0, q0, kt + 1)
        G_HALF(p0, q0, p1, q1, kt + 2)
    }
    G_HALF(p1, q1, p2, q2, nk - 5)
    G_HALF_NL(p0, q0, nk - 4)
    G_HALF_NL(p1, q1, nk - 3)
    G_HALF_NN(nk - 2)
    G_HALF_NN(nk - 1)
#undef G_HALF
#undef G_HALF_NL
#undef G_HALF_NN
#undef R_BURST1N
#undef R_BURST1S
#undef A_LD
#undef B_LD
#undef B_LD1
#undef R_BURST1
#undef R_BURST2
#undef X_LOAD
#undef X_STORE
#undef G_LOAD
#undef G_STORE
#undef F_LOAD
#undef G_MFMA
#undef SB
}

template <int WI, int WGJ, class GetF, class FinF>
DI void staged_rows(unsigned char* lds, int tid, GetF get, FinF fin) {
    constexpr int WGI = 8 / WGJ, BI = WGI * WI * 32, RS = BI * 2 + 16, ROWS = WGJ * 32, NCH = BI / 8;
    const int lane = tid & 63, wid = tid >> 6, wi = wid / WGJ, wj = wid % WGJ, h = lane >> 5, ln = lane & 31;
#pragma unroll
    for (int jt = 0; jt < 2; ++jt) {
        unsigned char* wrow = lds + (wj * 32 + ln) * RS + (wi * WI * 32 + 4 * h) * 2;
#pragma unroll
        for (int it = 0; it < WI; ++it)
#pragma unroll
            for (int g = 0; g < 4; ++g) *(u32x2*)(wrow + (it * 32 + 8 * g) * 2) = get(it, jt, g);
        __syncthreads();
#pragma unroll 1
        for (int c = 0; c < ROWS * NCH / NT; ++c) {
            const int idx = tid + c * NT, lr = idx / NCH, ch = idx % NCH;
            const u32x4 v = *(const u32x4*)(lds + lr * RS + ch * 16);
            fin((lr >> 5) * 64 + jt * 32 + (lr & 31), ch * 8, v);
        }
        __syncthreads();
    }
}

struct X8 { f32x4 a, b; };
template <int WI, int WGJ, class GetF, class LdF, class FinF>
DI void staged_rows_rmw(unsigned char* lds, int tid, GetF get, LdF ld, FinF fin) {
    constexpr int WGI = 8 / WGJ, BI = WGI * WI * 32, RS = BI * 2 + 16, ROWS = WGJ * 32, NCH = BI / 8, NIT = ROWS * NCH / NT;
    const int lane = tid & 63, wid = tid >> 6, wi = wid / WGJ, wj = wid % WGJ, h = lane >> 5, ln = lane & 31;
#pragma unroll
    for (int jt = 0; jt < 2; ++jt) {
        unsigned char* wrow = lds + (wj * 32 + ln) * RS + (wi * WI * 32 + 4 * h) * 2;
#pragma unroll
        for (int it = 0; it < WI; ++it)
#pragma unroll
            for (int g = 0; g < 4; ++g) *(u32x2*)(wrow + (it * 32 + 8 * g) * 2) = get(it, jt, g);
        constexpr int NGRP = 2, GSZ = NIT / NGRP;
        __syncthreads();
#pragma unroll 1
        for (int gq = 0; gq < NGRP; ++gq) {
            decltype(ld(0, 0)) fetched[GSZ];
#pragma unroll
            for (int c = 0; c < GSZ; ++c) {
                const int idx = tid + (gq * GSZ + c) * NT, lr = idx / NCH, ch = idx % NCH;
                fetched[c] = ld((lr >> 5) * 64 + jt * 32 + (lr & 31), ch * 8);
            }
#pragma unroll
            for (int c = 0; c < GSZ; ++c) {
                const int idx = tid + (gq * GSZ + c) * NT, lr = idx / NCH, ch = idx % NCH;
                const u32x4 v = *(const u32x4*)(lds + lr * RS + ch * 16);
                fin((lr >> 5) * 64 + jt * 32 + (lr & 31), ch * 8, v, fetched[c]);
            }
        }
        __syncthreads();
    }
}

template <int NROWS, int NCOLS>
DI void tile_rstd(const bf16_t* base, int ld, float* out, int tid) {
    constexpr int TPR = NT / NROWS, PER = NCOLS / TPR;
    const int row = tid / TPR, part = tid % TPR;
    const bf16_t* p = base + (size_t)row * ld + part * PER;
    float s = 0.f;
#pragma unroll
    for (int c = 0; c < PER / 8; ++c) {
        u32x4 v = *(const u32x4*)(p + c * 8);
#pragma unroll
        for (int e = 0; e < 4; ++e) { float a = bf_lo(v[e]), b = bf_hi(v[e]); s += a * a + b * b; }
    }
    s += __shfl_xor(s, 1);
    if (TPR == 4) s += __shfl_xor(s, 2);
    if (part == 0) out[row] = 1.0f / sqrtf(s * (1.0f / NCOLS) + EPS);
}

DI void sincos_acc(float angf, float& c, float& s) {
    const double a = (double)angf;
    const double kd = rint(a * 0.6366197723675814);
    double r = fma(-kd, 1.5707963267948966, a);
    r = fma(-kd, 6.123233995736766e-17, r);
    const int k = (int)kd;
    const double r2 = r * r;
    const double sp = r * (1.0 + r2 * (-1.0 / 6 + r2 * (1.0 / 120 + r2 * (-1.0 / 5040 + r2 * (1.0 / 362880 + r2 * (-1.0 / 39916800))))));
    const double cp = 1.0 + r2 * (-0.5 + r2 * (1.0 / 24 + r2 * (-1.0 / 720 + r2 * (1.0 / 40320 + r2 * (-1.0 / 3628800 + r2 * (1.0 / 479001600))))));
    const int q = k & 3;
    const double ss = (q == 0) ? sp : (q == 1) ? cp : (q == 2) ? -sp : -cp;
    const double cc = (q == 0) ? cp : (q == 1) ? -sp : (q == 2) ? -cp : sp;
    c = (float)cc; s = (float)ss;
}

DI void transpose_tile(bf16_t* dst, int dst_ld, int n0, int nvalid, int nwrite, const float* src, int src_ld, int col0, int k0,
                       const float* gain, float* ldsf, int tid) {
    if (nvalid > 0) {
#pragma unroll
        for (int r = 0; r < 2; ++r) {
            const int c = tid + NT * r, kk = c >> 4, n4 = (c & 15) * 4;
            f32x4 v = *(const f32x4*)(src + (size_t)(k0 + kk) * src_ld + col0 + n4);
            const float g = gain ? gain[k0 + kk] : 1.0f;
            float* d = ldsf + kk * 65 + n4;
            d[0] = v[0] * g; d[1] = v[1] * g; d[2] = v[2] * g; d[3] = v[3] * g;
        }
    }
    __syncthreads();
    const int n = tid >> 3, kc = tid & 7;
    if (n < nwrite) {
        u32x4 w = {0u, 0u, 0u, 0u};
        if (n < nvalid) {
            const float* s = ldsf + (kc * 8) * 65 + n;
            w[0] = pk2(s[0], s[65]); w[1] = pk2(s[130], s[195]); w[2] = pk2(s[260], s[325]); w[3] = pk2(s[390], s[455]);
        }
        *(u32x4*)(dst + (size_t)(n0 + n) * dst_ld + k0 + kc * 8) = w;
    }
    __syncthreads();
}

constexpr int WJ0 = 64, WJ1 = WJ0 + 768, WJ2 = WJ1 + 32, WJ3 = WJ2 + 16, WJ4 = WJ3 + 16, WJ5 = WJ4 + 16, WJ6 = WJ5 + 256, WJ7 = WJ6 + 256,
              WJ8 = WJ7 + 512, WJ9 = WJ8 + 96, WJ10 = WJ9 + 64, WJ11 = WJ10 + 256, WJ12 = WJ11 + 256, WJ13 = WJ12 + 256;
constexpr int W_EARLY = WJ5, W_ALL = WJ13;
DI void weight_tile(const Params& p, int id, float* ldsf, int tid) {
    unsigned char* ws = p.ws;
    bf16_t* wt1 = (bf16_t*)(ws + OFF_WT1);
    bf16_t* wz = (bf16_t*)(ws + OFF_WZ);
    bf16_t* wg = (bf16_t*)(ws + OFF_WG);
    if (id < WJ5) {
        int nt, kt, n0, nvalid = 64, nwrite = 64, col0;
        if (id < WJ0) { nt = id >> 4; kt = id & 15; n0 = nt * 64; col0 = nt * 64; }
        else if (id < WJ1) { const int j = id - WJ0; nt = j >> 4; kt = j & 15; n0 = 256 + nt * 64; col0 = 1440 + nt * 64; }
        else if (id < WJ2) { const int j = id - WJ1; nt = j >> 4; kt = j & 15; n0 = 3328 + nt * 64; col0 = 256 + nt * 64; }
        else if (id < WJ3) { kt = id - WJ2; n0 = 3456; col0 = 384; nvalid = 32; nwrite = 32; }
        else if (id < WJ4) { kt = id - WJ3; n0 = 3488; col0 = 4512; nvalid = 16; nwrite = 64; }
        else { kt = id - WJ4; n0 = 3552; col0 = 0; nvalid = 0; nwrite = 32; }
        transpose_tile(wt1, 1024, n0, nvalid, nwrite, p.w_in, 7600, col0, kt * 64, p.pre_g, ldsf, tid);
    } else if (id < WJ6) { const int j = id - WJ5; transpose_tile(wz, 1024, (j >> 4) * 64, 64, 64, p.w_in, 7600, 416 + (j >> 4) * 64, (j & 15) * 64, p.pre_g, ldsf, tid); }
    else if (id < WJ7) { const int j = id - WJ6; transpose_tile(wz, 1024, 1024 + (j >> 4) * 64, 64, 64, p.w_in, 7600, 4528 + (j >> 4) * 64, (j & 15) * 64, p.pre_g, ldsf, tid); }
    else if (id < WJ8) { const int j = id - WJ7; transpose_tile(wg, 1024, (j >> 4) * 64, 64, 64, p.w_in, 7600, 5552 + (j >> 4) * 64, (j & 15) * 64, p.pre_g, ldsf, tid); }
    else if (id < WJ9) { const int j = id - WJ8; transpose_tile((bf16_t*)(ws + OFF_WUQ), 256, (j >> 2) * 64, 64, 64, p.w_uq, 1536, (j >> 2) * 64, (j & 3) * 64, p.qn_g, ldsf, tid); }
    else if (id < WJ10) { const int j = id - WJ9; const int nt = j >> 1; const int col0 = nt < 16 ? nt * 128 : (nt - 16) * 128 + 64;
        transpose_tile((bf16_t*)(ws + OFF_WUKV), 128, nt * 64, 64, 64, p.w_ukv, 2048, col0, (j & 1) * 64, p.kvn_g, ldsf, tid); }
    else {
        const int j = id - WJ10; const int which = j >> 8, jj = j & 255;
        const float* src = which == 0 ? p.w_bm : which == 1 ? p.w_bf : p.w_out;
        bf16_t* dst = (bf16_t*)(ws + (which == 0 ? OFF_WBM : which == 1 ? OFF_WBF : OFF_WOUT));
        transpose_tile(dst, 1024, (jj >> 4) * 64, 64, 64, src, 1024, (jj >> 4) * 64, (jj & 15) * 64, nullptr, ldsf, tid);
    }
}

DI void phase0(const Params& p, unsigned char* smem, int tid) {
    unsigned char* ws = p.ws;
    const int bid = blockIdx.x, nblk = gridDim.x;
    const int gtid = bid * NT + tid, gsz = nblk * NT;
    if (bid == 0 && tid < 256) ((unsigned*)(ws + OFF_CTRL))[tid] = 0u;
    for (int i = gtid; i < NB * S; i += gsz) ((float*)(ws + OFF_SSQ))[i] = 0.f;
    for (int i = gtid; i < TP; i += gsz) ((float*)(ws + OFF_SSQC))[i] = 0.f;
    for (int i = gtid; i < LP * 16; i += gsz) {
        const int l = i >> 4, f = i & 15;
        const int fl = f & 3, fh = f >> 2;
        const double bd = fl == 0 ? 1.0 : fl == 1 ? 0.5623413251903491 : fl == 2 ? 0.31622776601683794 : 0.1778279410038923;
        const double sd = fh == 0 ? 1.0 : fh == 1 ? 0.1 : fh == 2 ? 0.01 : 0.001;
        const float invf = (float)(bd * sd);
        const float ang = (float)l * invf;
        float c, s; sincos_acc(ang, c, s);
        float* rp = (float*)(ws + OFF_ROPE);
        rp[l * 32 + f] = c; rp[l * 32 + 16 + f] = s;
    }
    for (int i = gtid; i < 2 * NB * NH * 64 * 12; i += gsz) {
        const int c = i % 12, row = i / 12;
        *(u32x2*)(ws + OFF_FVT + (size_t)row * (LP * 2) + L * 2 + c * 8) = (u32x2){0u, 0u};
    }
    {
        const int lane = tid & 63, gw = bid * (NT / 64) + (tid >> 6), nw = nblk * (NT / 64);
        bf16_t* hb = (bf16_t*)(ws + OFF_HB);
        float* rstd = (float*)(ws + OFF_RSTD0);
        for (int t = gw; t < TP; t += nw) {
            if (t < T) {
                const int b = t / L, l = t - b * L;
                const float* src = (l < NMETA) ? (p.meta + (size_t)l * D) : (p.x + ((size_t)b * S + (l - NMETA)) * D);
                float ss = 0.f;
#pragma unroll
                for (int c = 0; c < 4; ++c) {
                    f32x4 v = *(const f32x4*)(src + (c * 64 + lane) * 4);
                    ss += v[0] * v[0] + v[1] * v[1] + v[2] * v[2] + v[3] * v[3];
                    *(u32x2*)(hb + (size_t)t * D + (c * 64 + lane) * 4) = pk4(v[0], v[1], v[2], v[3]);
                }
#pragma unroll
                for (int o = 32; o > 0; o >>= 1) ss += __shfl_xor(ss, o);
                if (lane == 0) rstd[t] = 1.0f / sqrtf(ss * (1.0f / D) + EPS);
            } else {
#pragma unroll
                for (int c = 0; c < 4; ++c) *(u32x2*)(hb + (size_t)t * D + (c * 64 + lane) * 4) = (u32x2){0u, 0u};
                if (lane == 0) rstd[t] = 0.f;
            }
        }
    }
    {
        float* ldsf = (float*)(smem + LDS_MISC);
        const int nw = (gridDim.x == 256) ? W_EARLY : W_ALL;
        for (int id = bid; id < nw; id += nblk) weight_tile(p, id, ldsf, tid);
    }
}

template <int MODE>
DI void phase1(const Params& p, unsigned char* smem, int tid) {
    unsigned char* ws = p.ws;
    unsigned char* ob = (unsigned char*)p.out;
    const bf16_t* hb = (const bf16_t*)(ws + OFF_HB);
    const bf16_t* wt1 = (const bf16_t*)(ws + OFF_WT1);
    const float* rstd = (const float*)(ws + OFF_RSTD0);
    unsigned char* lds = smem + LDS_MISC;
    const int xcd = blockIdx.x & 7, cu = blockIdx.x >> 3, per_round = gridDim.x;
    for (int rb = 0; rb < 14 * 65; rb += per_round) {
        const int idp = rb + xcd * (per_round >> 3) + cu;
        if (idp >= 14 * 65) {
            if (gridDim.x == 256) {
                constexpr int NIDLE = 4 * 256 - 14 * 65;
                int ti = tid; asm volatile("" : "+v"(ti));
                for (int id = W_EARLY + (idp - 14 * 65); id < W_ALL; id += NIDLE) weight_tile(p, id, (float*)lds, ti);
            }
            continue;
        }
        int F, tt;
        if (idp < 16 * 56) { const int g = idp / 56, rem = idp - g * 56; F = rem >> 2; tt = g * 4 + (rem & 3); }
        else { F = idp - 16 * 56; tt = 64; }
        f32x16 acc[4][2];
        if (F < 9 || F == 13) {
            const int rowbase = F * 256;
            int tl = tid; asm volatile("" : "+v"(tl));
            gemm_tile3r<4, 4, MODE>(wt1 + (size_t)rowbase * 1024, 1024, hb + (size_t)tt * 256 * 1024, 1024, 1024, lds, acc, tl);
            int te = tid; asm volatile("" : "+v"(te));
            const int lane = te & 63, wid = te >> 6, wi = wid >> 2, wj = wid & 3, h = lane >> 5, ln = lane & 31;
            if (F < 9) {
                float rsj[2];
#pragma unroll
                for (int jt = 0; jt < 2; ++jt) rsj[jt] = rstd[tt * 256 + wj * 64 + jt * 32 + ln] * ((F >= 1 && F <= 4) ? FOX_QS : 1.0f);
                bf16_t* dbase = F == 0 ? (bf16_t*)(ob + OUT_CQ) : F <= 4 ? (bf16_t*)(ws + OFF_FQ) + (F - 1) * 256 : (bf16_t*)(ws + OFF_FK) + (F - 5) * 256;
                const int dld = F == 0 ? 256 : 1024;
                if (F == 0) {
#pragma unroll
                    for (int jt = 0; jt < 2; ++jt) {
                        float sq = 0.f;
#pragma unroll
                        for (int it = 0; it < 4; ++it)
#pragma unroll
                            for (int r = 0; r < 16; ++r) { const float v = acc[it][jt][r] * rsj[jt]; sq += v * v; }
                        { const auto sw = __builtin_amdgcn_permlane32_swap(__float_as_uint(sq), __float_as_uint(sq), false, false);
                          sq = __uint_as_float(sw[0]) + __uint_as_float(sw[1]); }
                        if (h == 0) atomicAdd((float*)(ws + OFF_SSQC) + tt * 256 + wj * 64 + jt * 32 + ln, sq);
                    }
                }
                staged_rows<4, 4>(lds, te,
                    [&](int it, int jt, int g) { const float sc = rsj[jt]; return pk4(acc[it][jt][4 * g] * sc, acc[it][jt][4 * g + 1] * sc, acc[it][jt][4 * g + 2] * sc, acc[it][jt][4 * g + 3] * sc); },
                    [&](int row, int col, u32x4 v) { *(u32x4*)(dbase + (size_t)(tt * 256 + row) * dld + col) = v; });
                continue;
            }
#pragma unroll
            for (int jt = 0; jt < 2; ++jt) {
                const int t = tt * 256 + wj * 64 + jt * 32 + ln;
                const float rs = rstd[t];
                if (wi == 0) {
                    float sq = 0.f;
#pragma unroll
                    for (int it = 0; it < 4; ++it)
#pragma unroll
                        for (int r = 0; r < 16; ++r) { const float v = acc[it][jt][r] * rs; sq += v * v; }
                    { const auto sw = __builtin_amdgcn_permlane32_swap(__float_as_uint(sq), __float_as_uint(sq), false, false);
                      sq = __uint_as_float(sw[0]) + __uint_as_float(sw[1]); }
                    if (h == 0) ((float*)(ws + OFF_RKV))[t] = 1.0f / sqrtf(sq * (1.0f / 128) + EPS);
                }
#pragma unroll
                for (int it = 0; it < 4; ++it) {
                    const int fb = rowbase + wi * 128 + it * 32;
                    if (fb < 3456) {
                        bf16_t* dst; float sc = rs;
                        if (fb < 256) dst = (bf16_t*)(ob + OUT_CQ) + (size_t)t * 256 + fb;
                        else if (fb < 1280) { dst = (bf16_t*)(ws + OFF_FQ) + (size_t)t * 1024 + (fb - 256); sc = rs * FOX_QS; }
                        else if (fb < 2304) dst = (bf16_t*)(ws + OFF_FK) + (size_t)t * 1024 + (fb - 1280);
                        else dst = (bf16_t*)(ob + OUT_CKV) + (size_t)t * 128 + (fb - 3328);
#pragma unroll
                        for (int g = 0; g < 4; ++g)
                            *(u32x2*)(dst + 8 * g + 4 * h) = pk4(acc[it][jt][4 * g] * sc, acc[it][jt][4 * g + 1] * sc, acc[it][jt][4 * g + 2] * sc, acc[it][jt][4 * g + 3] * sc);
                    } else if (fb == 3456) {
                        float* dst = (float*)(ob + OUT_KPE) + (size_t)t * 32;
#pragma unroll
                        for (int g = 0; g < 4; ++g)
                            *(f32x4*)(dst + 8 * g + 4 * h) = (f32x4){acc[it][jt][4 * g] * rs, acc[it][jt][4 * g + 1] * rs, acc[it][jt][4 * g + 2] * rs, acc[it][jt][4 * g + 3] * rs};
                    } else if (fb == 3488) {
                        float* dst = (float*)(ws + OFF_FLOGIT) + (size_t)t * 16;
#pragma unroll
                        for (int g = 0; g < 2; ++g)
                            *(f32x4*)(dst + 8 * g + 4 * h) = (f32x4){acc[it][jt][4 * g] * rs, acc[it][jt][4 * g + 1] * rs, acc[it][jt][4 * g + 2] * rs, acc[it][jt][4 * g + 3] * rs};
                    }
                }
            }
        } else {
            const int fn = F - 9;
            int tl = tid; asm volatile("" : "+v"(tl));
            gemm_tile3r<4, 4, MODE>(hb + (size_t)tt * 256 * 1024, 1024, wt1 + (size_t)(2304 + fn * 256) * 1024, 1024, 1024, lds, acc, tl);
            int te = tid; asm volatile("" : "+v"(te));
            const int lane = te & 63, wid = te >> 6, wi = wid >> 2, h = lane >> 5; (void)lane;
            bf16_t* fvt = (bf16_t*)(ws + OFF_FVT);
            staged_rows<4, 4>(lds, te,
                [&](int it, int jt, int g) { const f32x4 rs = *(const f32x4*)(rstd + tt * 256 + wi * 128 + it * 32 + 8 * g + 4 * h);
                    return pk4(acc[it][jt][4 * g] * rs[0], acc[it][jt][4 * g + 1] * rs[1], acc[it][jt][4 * g + 2] * rs[2], acc[it][jt][4 * g + 3] * rs[3]); },
                [&](int row, int col, u32x4 v) { const int feat = fn * 256 + row, t = tt * 256 + col;
                    if (t < T) { const int b = t / L, l = t - b * L; *(u32x4*)(fvt + ((size_t)(b * NH + (feat >> 6)) * 64 + (feat & 63)) * LP + l) = v; } });
        }
    }
}

DI float log_sigmoid(float x) { return fminf(x, 0.f) - log1pf(__expf(-fabsf(x))); }

DI void phase2(const Params& p, unsigned char* smem, int tid) {
    unsigned char* ws = p.ws;
    unsigned char* ob = (unsigned char*)p.out;
    unsigned char* lds = smem + LDS_MISC;
    float* lrs = (float*)smem;
    const bf16_t* cq = (const bf16_t*)(ob + OUT_CQ);
    const bf16_t* ckv = (const bf16_t*)(ob + OUT_CKV);
    const float* rope = (const float*)(ws + OFF_ROPE);
    constexpr int U_SCAN = 64, U_Q = U_SCAN + 6 * 65, U_KN = U_Q + 4 * 65, U_V = U_KN + 4 * 65, U_KPE = U_V + 130, U_KMAX = U_KPE + 129;
    const int tid_in = tid;
    for (int id = blockIdx.x; id < U_KMAX; id += gridDim.x) {
        __syncthreads();
        int tid = tid_in; asm volatile("" : "+v"(tid));
        const int lane = tid & 63, wid = tid >> 6; (void)lane; (void)wid;
        if (id < U_SCAN) {
            const int b = id >> 4, hd = id & 15;
            const float fb = p.fox_b[hd];
            const float* fl = (const float*)(ws + OFF_FLOGIT) + (size_t)b * L * 16 + hd;
            float* wsum = (float*)smem;
            const int l0 = tid * 9;
            float v[9];
#pragma unroll
            for (int i = 0; i < 9; ++i) { const int l = l0 + i; v[i] = (l < L) ? fl[(size_t)l * 16] : 0.f; }
            float run = 0.f;
#pragma unroll
            for (int i = 0; i < 9; ++i) { const int l = l0 + i; run += (l < L) ? log_sigmoid(v[i] + fb) : 0.f; v[i] = run; }
            float inc = run;
#pragma unroll
            for (int o = 1; o < 64; o <<= 1) { const float u = __shfl_up(inc, o); if (lane >= o) inc += u; }
            if (lane == 63) wsum[wid] = inc;
            __syncthreads();
            float base = inc - run;
            for (int w = 0; w < wid; ++w) base += wsum[w];
            float* bias = (float*)(ws + OFF_BIAS) + (size_t)(b * NH + hd) * LP;
#pragma unroll
            for (int i = 0; i < 9; ++i) { const int l = l0 + i; if (l < LP) bias[l] = (l < L) ? -(base + v[i]) * LOG2E : 0.f; }
            __syncthreads();
        } else if (id < U_Q) {
            const int j = id - U_SCAN, f = j / 65, tt = j - f * 65;
            f32x16 acc[4][2];
            { int tl = tid; asm volatile("" : "+v"(tl));
              gemm_tile2<4, 4>((const bf16_t*)(ws + OFF_WUQ) + (size_t)f * 256 * 256, 256, cq + (size_t)tt * 256 * 256, 256, 256, lds, acc, tl); }
            int te = tid; asm volatile("" : "+v"(te));
            const int lane = te & 63, wid = te >> 6, wi = wid >> 2, wj = wid & 3, h = lane >> 5, ln = lane & 31; (void)wi; (void)wj; (void)h; (void)ln;
#pragma unroll
            for (int jt = 0; jt < 2; ++jt) {
                const int tl = wj * 64 + jt * 32 + ln, t = tt * 256 + tl;
                const float rq = MLA_QS / sqrtf(((const float*)(ws + OFF_SSQC))[t] * (1.0f / 256) + EPS);
                const int pos = t % L;
#pragma unroll
                for (int it = 0; it < 4; ++it) {
                    const int blk = (f * 256 + wi * 128 + it * 32) >> 5, hd = blk / 3, part = blk - hd * 3;
                    if (part < 2) {
#pragma unroll
                        for (int r = 0; r < 16; ++r) acc[it][jt][r] *= rq;
                    } else {
                        const float* rp = rope + (size_t)pos * 32;
#pragma unroll
                        for (int g = 0; g < 2; ++g) {
                            const f32x4 c4 = *(const f32x4*)(rp + 8 * g + 4 * h), s4 = *(const f32x4*)(rp + 16 + 8 * g + 4 * h);
#pragma unroll
                            for (int e = 0; e < 4; ++e) {
                                const float x1 = acc[it][jt][4 * g + e] * rq, x2 = acc[it][jt][4 * g + e + 8] * rq;
                                acc[it][jt][4 * g + e] = x1 * c4[e] - x2 * s4[e]; acc[it][jt][4 * g + e + 8] = x1 * s4[e] + x2 * c4[e];
                            }
                        }
                    }
                }
            }
            {
                bf16_t* qn = (bf16_t*)(ws + OFF_QN); bf16_t* qpe = (bf16_t*)(ws + OFF_QPE);
                staged_rows<4, 4>(lds, te,
                    [&](int it, int jt, int g) { return pk4(acc[it][jt][4 * g], acc[it][jt][4 * g + 1], acc[it][jt][4 * g + 2], acc[it][jt][4 * g + 3]); },
                    [&](int row, int col, u32x4 v) { const int t = tt * 256 + row, ff = f * 256 + col, blk = ff >> 5, hd = blk / 3, part = blk - hd * 3;
                        bf16_t* d = part < 2 ? qn + (size_t)t * 1024 + hd * 64 + part * 32 + (ff & 31) : qpe + (size_t)t * 512 + hd * 32 + (ff & 31);
                        *(u32x4*)d = v; });
            }
        } else if (id < U_KN) {
            const int j = id - U_Q, f = j / 65, tt = j - f * 65;
            f32x16 acc[4][2];
            { int tl = tid; asm volatile("" : "+v"(tl));
              gemm_tile2<4, 4>((const bf16_t*)(ws + OFF_WUKV) + (size_t)f * 256 * 128, 128, ckv + (size_t)tt * 256 * 128, 128, 128, lds, acc, tl); }
            int te = tid; asm volatile("" : "+v"(te));
            const int lane = te & 63, wid = te >> 6, wi = wid >> 2, wj = wid & 3, h = lane >> 5, ln = lane & 31; (void)wi; (void)wj; (void)h; (void)ln;
            {
                float rk[2];
#pragma unroll
                for (int jt = 0; jt < 2; ++jt) rk[jt] = ((const float*)(ws + OFF_RKV))[tt * 256 + wj * 64 + jt * 32 + ln];
                bf16_t* km = (bf16_t*)(ob + OUT_KM);
                staged_rows<4, 4>(lds, te,
                    [&](int it, int jt, int g) { const float sc = rk[jt]; return pk4(acc[it][jt][4 * g] * sc, acc[it][jt][4 * g + 1] * sc, acc[it][jt][4 * g + 2] * sc, acc[it][jt][4 * g + 3] * sc); },
                    [&](int row, int col, u32x4 v) { const int t = tt * 256 + row, ff = f * 256 + col;
                        *(u32x4*)(km + (size_t)t * 1536 + (ff >> 6) * 96 + (ff & 63)) = v; });
            }
        } else if (id < U_V) {
            const int j = id - U_KN, fn = j / 65, tt = j - fn * 65;
            f32x16 acc[4][2];
            { int tl = tid; asm volatile("" : "+v"(tl));
              gemm_tile2<4, 4>(ckv + (size_t)tt * 256 * 128, 128, (const bf16_t*)(ws + OFF_WUKV) + (size_t)(1024 + fn * 256) * 128, 128, 128, lds, acc, tl); }
            int te = tid; asm volatile("" : "+v"(te));
            const int lane = te & 63, wid = te >> 6, wi = wid >> 2, wj = wid & 3, h = lane >> 5, ln = lane & 31; (void)wi; (void)wj; (void)h; (void)ln;
            bf16_t* vmt = (bf16_t*)(ws + OFF_VMT);
            staged_rows<4, 4>(lds, te,
                [&](int it, int jt, int g) { const f32x4 rs = *(const f32x4*)((const float*)(ws + OFF_RKV) + tt * 256 + wi * 128 + it * 32 + 8 * g + 4 * h);
                    return pk4(acc[it][jt][4 * g] * rs[0], acc[it][jt][4 * g + 1] * rs[1], acc[it][jt][4 * g + 2] * rs[2], acc[it][jt][4 * g + 3] * rs[3]); },
                [&](int row, int col, u32x4 v) { const int feat = fn * 256 + row, t = tt * 256 + col;
                    if (t < T) { const int b = t / L, l = t - b * L; *(u32x4*)(vmt + ((size_t)(b * NH + (feat >> 6)) * 64 + (feat & 63)) * LP + l) = v; } });
        } else if (id >= U_KPE) {
            const int row = (id - U_KPE) * 128 + (tid >> 2), q = tid & 3;
            float v[4] = {0.f, 0.f, 0.f, 0.f};
            if (row < T) {
                const bf16_t* kp = (const bf16_t*)(ws + OFF_FK) + (size_t)row * 1024 + q * 256;
#pragma unroll
                for (int hh = 0; hh < 4; ++hh)
#pragma unroll
                    for (int c = 0; c < 8; ++c) {
                        const u32x4 w = *(const u32x4*)(kp + hh * 64 + c * 8);
#pragma unroll
                        for (int e = 0; e < 4; ++e) { const float a = bf_lo(w[e]), b2 = bf_hi(w[e]); v[hh] += a * a + b2 * b2; }
                    }
            }
#pragma unroll
            for (int hh = 0; hh < 4; ++hh) {
#pragma unroll
                for (int o = 4; o < 64; o <<= 1) v[hh] = fmaxf(v[hh], __shfl_xor(v[hh], o));
            }
            const int row0 = (id - U_KPE) * 128 + wid * 16;
            if (lane < 4 && row0 < T) {
                unsigned* km2 = (unsigned*)(ws + OFF_CTRL) + 64 + (row0 / L) * NH + lane * 4;
#pragma unroll
                for (int hh = 0; hh < 4; ++hh) atomicMax(km2 + hh, __float_as_uint(v[hh]));
            }
        } else {
            const int item = (id - U_V) * NT + tid;
            const int t = item >> 2, q = item & 3;
            const int pos = t % L;
            const float* kp = (const float*)(ob + OUT_KPE) + (size_t)t * 32 + q * 4;
            const f32x4 x1 = *(const f32x4*)kp, x2 = *(const f32x4*)(kp + 16);
            const f32x4 c4 = *(const f32x4*)(rope + (size_t)pos * 32 + q * 4), s4 = *(const f32x4*)(rope + (size_t)pos * 32 + 16 + q * 4);
            const u32x2 y1 = pk4(x1[0] * c4[0] - x2[0] * s4[0], x1[1] * c4[1] - x2[1] * s4[1], x1[2] * c4[2] - x2[2] * s4[2], x1[3] * c4[3] - x2[3] * s4[3]);
            const u32x2 y2 = pk4(x1[0] * s4[0] + x2[0] * c4[0], x1[1] * s4[1] + x2[1] * c4[1], x1[2] * s4[2] + x2[2] * c4[2], x1[3] * s4[3] + x2[3] * c4[3]);
            bf16_t* dst = (bf16_t*)(ob + OUT_KM) + (size_t)t * 1536 + 64 + q * 4;
#pragma unroll
            for (int hd = 0; hd < NH; ++hd) { *(u32x2*)(dst + hd * 96) = y1; *(u32x2*)(dst + hd * 96 + 16) = y2; }
        }
    }
}

template <int DK, bool FOX>
DI void attn_unit(const bf16_t* qa, int ldqa, const bf16_t* qb, int ldqb,
                  const bf16_t* kbase, int ldk,
                  const bf16_t* vt,
                  const float* bias,
                  bf16_t* obase, int ldo,
                  int qi, unsigned char* lds, int tid, float kmax2 = 0.f, int* flags = nullptr) {
    constexpr int KS = DK / 16, KROW = DK * 2 + 16, VROW = 136;
    constexpr int KBYTES = 64 * KROW, VBYTES = 64 * VROW, STG = KBYTES + VBYTES + 256;
    constexpr int KCH = DK / 8;
    constexpr int NKC = 64 * KCH / NT;
    const int lane = tid & 63, wid = tid >> 6, h = lane >> 5, ln = lane & 31;
    const int q0 = NMETA + 256 * qi;
    const int qw0 = q0 + 32 * wid;
    const int myq = qw0 + ln;
    const int nkt = (q0 + 255) / 64 + 1;
    bf16x8 qf[KS];
#pragma unroll
    for (int ks = 0; ks < KS; ++ks) {
        if (ks < 4) qf[ks] = *(const bf16x8*)(qa + (size_t)myq * ldqa + ks * 16 + h * 8);
        else qf[ks] = *(const bf16x8*)(qb + (size_t)myq * ldqb + (ks - 4) * 16 + h * 8);
    }
    f32x16 o[2];
#pragma unroll
    for (int d = 0; d < 2; ++d)
#pragma unroll
        for (int r = 0; r < 16; ++r) o[d][r] = 0.f;
    float m = -INFINITY, lsum = 0.f;
    float qkb = 0.f; bool wdone = false;
    if (FOX) {
        float q2 = 0.f;
#pragma unroll
        for (int ks = 0; ks < 4; ++ks) {
            const u32x4 w = __builtin_bit_cast(u32x4, qf[ks]);
#pragma unroll
            for (int e = 0; e < 4; ++e) { const float a = bf_lo(w[e]), b2 = bf_hi(w[e]); q2 += a * a + b2 * b2; }
        }
        { const auto sw = __builtin_amdgcn_permlane32_swap(__float_as_uint(q2), __float_as_uint(q2), false, false);
          q2 = __uint_as_float(sw[0]) + __uint_as_float(sw[1]); }
        qkb = sqrtf(q2 * kmax2) * 1.01f + 0.01f;
    }
    constexpr int NK2 = (64 * KCH + NT - 1) / NT;
    u32x4 kr[NK2]; u32x4 vr; float br = 0.f;
    auto gload = [&](int j) {
#pragma unroll
        for (int r = 0; r < NK2; ++r) {
            const int c = tid + NT * r;
            if (c < 64 * KCH) { const int row = c / KCH, ch = c - row * KCH; kr[r] = *(const u32x4*)(kbase + (size_t)(64 * j + row) * ldk + ch * 8); }
        }
        { const int row = tid >> 3, ch = tid & 7; vr = *(const u32x4*)(vt + (size_t)row * LP + 64 * j + ch * 8); }
        if (FOX) { if (tid < 64) br = bias[64 * j + tid]; }
    };
    auto lstore = [&](int st) {
        unsigned char* base = lds + st * STG;
#pragma unroll
        for (int r = 0; r < NK2; ++r) {
            const int c = tid + NT * r;
            if (c < 64 * KCH) { const int row = c / KCH, ch = c - row * KCH; *(u32x4*)(base + row * KROW + ch * 16) = kr[r]; }
        }
        { const int row = tid >> 3, ch = tid & 7; unsigned char* d = base + KBYTES + row * VROW + ch * 16;
          *(u32x2*)d = (u32x2){vr[0], vr[1]}; *(u32x2*)(d + 8) = (u32x2){vr[2], vr[3]}; }
        if (FOX) { if (tid < 64) *(float*)(base + KBYTES + VBYTES + tid * 4) = br; }
    };
    const int jlast = nkt - 1;
    gload(jlast); lstore(0);
    __syncthreads();
    m = -1e30f;
#pragma unroll 1
    for (int itn = 0; itn < nkt; ++itn) {
        const int j = jlast - itn;
        const int st = itn & 1;
        if (j > 0) gload(j - 1);
        if (FOX && !wdone && 64 * j <= qw0 + 31) {
            const float bmax = *(const float*)(lds + st * STG + KBYTES + VBYTES + 63 * 4);
            const bool need = !((m > -1e29f) && (qkb + bmax < m - 40.0f));
            if (__builtin_amdgcn_ballot_w64(need) == 0ull) wdone = true;
        }
        if (!wdone && 64 * j <= qw0 + 31) {
            const unsigned char* kb = lds + st * STG;
            const unsigned char* vb = kb + KBYTES;
            f32x16 s[2];
            if (FOX) {
                const float* bl = (const float*)(vb + VBYTES);
#pragma unroll
                for (int t2 = 0; t2 < 2; ++t2)
#pragma unroll
                    for (int g = 0; g < 4; ++g) {
                        const f32x4 b4 = *(const f32x4*)(bl + t2 * 32 + 8 * g + 4 * h);
                        s[t2][4 * g] = b4[0]; s[t2][4 * g + 1] = b4[1]; s[t2][4 * g + 2] = b4[2]; s[t2][4 * g + 3] = b4[3];
                    }
            } else {
#pragma unroll
                for (int t2 = 0; t2 < 2; ++t2)
#pragma unroll
                    for (int r = 0; r < 16; ++r) s[t2][r] = 0.f;
            }
            bf16x8 kf[KS][2];
#pragma unroll
            for (int ks = 0; ks < KS; ++ks)
#pragma unroll
                for (int t2 = 0; t2 < 2; ++t2) kf[ks][t2] = *(const bf16x8*)(kb + (t2 * 32 + ln) * KROW + ks * 32 + h * 16);
            __builtin_amdgcn_sched_barrier(0);
#pragma unroll
            for (int ks = 0; ks < KS; ++ks)
#pragma unroll
                for (int t2 = 0; t2 < 2; ++t2) s[t2] = __builtin_amdgcn_mfma_f32_32x32x16_bf16(kf[ks][t2], qf[ks], s[t2], 0, 0, 0);
            __builtin_amdgcn_sched_barrier(0);
            u32x2 vf[4][2][2];
#pragma unroll
            for (int kk = 0; kk < 4; ++kk)
#pragma unroll
                for (int d = 0; d < 2; ++d) {
                    const unsigned char* va = vb + (d * 32 + ln) * VROW + (16 * kk + 4 * h) * 2;
                    vf[kk][d][0] = *(const u32x2*)va; vf[kk][d][1] = *(const u32x2*)(va + 16);
                }
            __builtin_amdgcn_sched_barrier(0);
            if (64 * j + 63 > qw0) {
                const int thr = myq - 64 * j - 4 * h;
#pragma unroll
                for (int t2 = 0; t2 < 2; ++t2)
#pragma unroll
                    for (int r = 0; r < 16; ++r) { if (((r & 3) + 8 * (r >> 2) + 32 * t2) > thr) s[t2][r] = -INFINITY; }
            }
            float mxa[2];
#pragma unroll
            for (int t2 = 0; t2 < 2; ++t2) {
                float x0 = fmaxf(fmaxf(s[t2][0], s[t2][1]), s[t2][2]);
                float x1 = fmaxf(fmaxf(s[t2][3], s[t2][4]), s[t2][5]);
                float x2 = fmaxf(fmaxf(s[t2][6], s[t2][7]), s[t2][8]);
                float x3 = fmaxf(fmaxf(s[t2][9], s[t2][10]), s[t2][11]);
                float x4 = fmaxf(fmaxf(s[t2][12], s[t2][13]), s[t2][14]);
                mxa[t2] = fmaxf(fmaxf(fmaxf(x0, x1), x2), fmaxf(fmaxf(x3, x4), s[t2][15]));
            }
            float mx = fmaxf(mxa[0], mxa[1]);
            { const auto sw = __builtin_amdgcn_permlane32_swap(__float_as_uint(mx), __float_as_uint(mx), false, false);
              mx = fmaxf(__uint_as_float(sw[0]), __uint_as_float(sw[1])); }
            if (__builtin_amdgcn_ballot_w64(mx > m + 8.0f) != 0ull) {
                const float mn = fmaxf(m, mx);
                const float alpha = __builtin_amdgcn_exp2f(m - mn);
                m = mn;
                lsum *= alpha;
#pragma unroll
                for (int d = 0; d < 2; ++d)
#pragma unroll
                    for (int r = 0; r < 16; ++r) o[d][r] *= alpha;
            }
            float ps0 = 0.f, ps1 = 0.f, ps2 = 0.f, ps3 = 0.f;
#pragma unroll
            for (int t2 = 0; t2 < 2; ++t2)
#pragma unroll
                for (int r = 0; r < 16; r += 4) {
                    const float e0 = __builtin_amdgcn_exp2f(s[t2][r] - m), e1 = __builtin_amdgcn_exp2f(s[t2][r + 1] - m);
                    const float e2 = __builtin_amdgcn_exp2f(s[t2][r + 2] - m), e3 = __builtin_amdgcn_exp2f(s[t2][r + 3] - m);
                    s[t2][r] = e0; s[t2][r + 1] = e1; s[t2][r + 2] = e2; s[t2][r + 3] = e3;
                    ps0 += e0; ps1 += e1; ps2 += e2; ps3 += e3;
                }
            lsum += (ps0 + ps1) + (ps2 + ps3);
#pragma unroll
            for (int kk = 0; kk < 4; ++kk) {
                const int t2 = kk >> 1, s8 = (kk & 1) * 8;
                u32x4 pw;
                pw[0] = pk2(s[t2][s8 + 0], s[t2][s8 + 1]); pw[1] = pk2(s[t2][s8 + 2], s[t2][s8 + 3]);
                pw[2] = pk2(s[t2][s8 + 4], s[t2][s8 + 5]); pw[3] = pk2(s[t2][s8 + 6], s[t2][s8 + 7]);
                const bf16x8 pf = __builtin_bit_cast(bf16x8, pw);
#pragma unroll
                for (int d = 0; d < 2; ++d) {
                    const u32x4 vw = {vf[kk][d][0][0], vf[kk][d][0][1], vf[kk][d][1][0], vf[kk][d][1][1]};
                    o[d] = __builtin_amdgcn_mfma_f32_32x32x16_bf16(__builtin_bit_cast(bf16x8, vw), pf, o[d], 0, 0, 0);
                }
            }
        }
        if (j > 0) lstore(st ^ 1);
        if (FOX) {
            if (lane == 0) flags[(itn & 1) * 8 + wid] = wdone ? 1 : 0;
            __syncthreads();
            const u32x4 f0 = *(const u32x4*)(flags + (itn & 1) * 8), f1 = *(const u32x4*)(flags + (itn & 1) * 8 + 4);
            if ((f0[0] & f0[1] & f0[2] & f0[3] & f1[0] & f1[1] & f1[2] & f1[3]) != 0u) break;
        } else {
            __syncthreads();
        }
    }
    if (FOX) __syncthreads();
    { const auto sw = __builtin_amdgcn_permlane32_swap(__float_as_uint(lsum), __float_as_uint(lsum), false, false);
      lsum = __uint_as_float(sw[0]) + __uint_as_float(sw[1]); }
    const float inv = 1.0f / lsum;
    {
        unsigned char* sb = lds + 2 * STG + wid * (32 * 144);
#pragma unroll
        for (int d = 0; d < 2; ++d)
#pragma unroll
            for (int g = 0; g < 4; ++g)
                *(u32x2*)(sb + ln * 144 + (d * 32 + 8 * g + 4 * h) * 2) = pk4(o[d][4 * g] * inv, o[d][4 * g + 1] * inv, o[d][4 * g + 2] * inv, o[d][4 * g + 3] * inv);
        __builtin_amdgcn_fence(__ATOMIC_RELEASE, "wavefront");
        __builtin_amdgcn_wave_barrier();
        __builtin_amdgcn_fence(__ATOMIC_ACQUIRE, "wavefront");
#pragma unroll
        for (int ps = 0; ps < 4; ++ps) {
            const int row = ps * 8 + (lane >> 3), ch = lane & 7;
            const u32x4 v = *(const u32x4*)(sb + row * 144 + ch * 16);
            *(u32x4*)(obase + (size_t)(qw0 + row) * ldo + ch * 8) = v;
        }
    }
}

DI void phase3(const Params& p, unsigned char* smem, int tid, int cidx) {
    unsigned char* ws = p.ws;
    unsigned char* ob = (unsigned char*)p.out;
    unsigned char* lds = smem + LDS_MISC;
    unsigned* ctr = (unsigned*)(ws + OFF_CTRL) + cidx;
    int* sh = (int*)smem;
    int* flags = (int*)(smem + 1056);
    const float* kmax2 = (const float*)(ws + OFF_CTRL) + 64;
    if (gridDim.x == 256) {
        const int xcd = blockIdx.x & 7, cu = blockIdx.x >> 3, s4 = (cu >> 3) & 3, j8 = cu & 7;
        for (int r = 0; r < 2; ++r) {
            const int bh = (r * 4 + s4) * 8 + xcd, b = bh >> 4, hd = bh & 15;
            const size_t t0 = (size_t)b * L;
            for (int half = 0; half < 2; ++half) {
                const int qi = half == 0 ? 15 - j8 : j8;
                bf16_t* qn = (bf16_t*)(ws + OFF_QN) + t0 * 1024 + hd * 64;
                attn_unit<96, false>(qn, 1024, (const bf16_t*)(ws + OFF_QPE) + t0 * 512 + hd * 32, 512,
                                     (const bf16_t*)(ob + OUT_KM) + t0 * 1536 + hd * 96, 1536,
                                     (const bf16_t*)(ws + OFF_VMT) + (size_t)(b * NH + hd) * 64 * LP, nullptr, qn, 1024, qi, lds, tid);
            }
        }
    }
    const int nun = (gridDim.x == 256) ? 1024 : 2048;
    for (;;) {
        if (tid == 0) sh[0] = (int)atomicAdd(ctr, 1u);
        __syncthreads();
        const int u = sh[0];
        __syncthreads();
        if (u >= nun) break;
        int qi, type, bh;
        if (gridDim.x == 256) { qi = 15 - (u >> 6); bh = u & 63; type = 1; }
        else { qi = 15 - (u >> 7); const int rem = u & 127; type = rem & 1; bh = rem >> 1; }
        const int b = bh >> 4, hd = bh & 15;
        const size_t t0 = (size_t)b * L;
        if (type == 0) {
            bf16_t* qn = (bf16_t*)(ws + OFF_QN) + t0 * 1024 + hd * 64;
            attn_unit<96, false>(qn, 1024, (const bf16_t*)(ws + OFF_QPE) + t0 * 512 + hd * 32, 512,
                                 (const bf16_t*)(ob + OUT_KM) + t0 * 1536 + hd * 96, 1536,
                                 (const bf16_t*)(ws + OFF_VMT) + (size_t)(b * NH + hd) * 64 * LP, nullptr, qn, 1024, qi, lds, tid);
        } else {
            bf16_t* fq = (bf16_t*)(ws + OFF_FQ) + t0 * 1024 + hd * 64;
            attn_unit<64, true>(fq, 1024, fq, 1024, (const bf16_t*)(ws + OFF_FK) + t0 * 1024 + hd * 64, 1024,
                                (const bf16_t*)(ws + OFF_FVT) + (size_t)(b * NH + hd) * 64 * LP,
                                (const float*)(ws + OFF_BIAS) + (size_t)(b * NH + hd) * LP, fq, 1024, qi, lds, tid, kmax2[b * NH + hd], flags);
        }
    }
}

DI int real_tile_row(int tt) { return (tt >> 5) * L + NMETA + (tt & 31) * 128; }

DI int real_tile_row256(int tt) { return (tt >> 4) * L + NMETA + (tt & 15) * 256; }
constexpr size_t OFF_G = OFF_FVT;
static_assert((size_t)8 * 64 * 256 * 256 * 2 <= 2 * (size_t)NB * NH * 64 * LP * 2, "gate buffer too large");
DI void phase3b(const Params& p, unsigned char* smem, int tid) {
    unsigned char* ws = p.ws;
    const bf16_t* hb = (const bf16_t*)(ws + OFF_HB);
    const float* rstd = (const float*)(ws + OFF_RSTD0);
    unsigned char* lds = smem + LDS_MISC;
    const int xcd = blockIdx.x & 7, cu = blockIdx.x >> 3, per_round = gridDim.x;
    auto tile_ptrs = [&](int rb, const bf16_t*& P, const bf16_t*& Q) __attribute__((always_inline)) -> bool {
        const int idp = rb + xcd * (per_round >> 3) + cu;
        if (rb >= 16 * 64 || idp >= 16 * 64) return false;
        const int half = idp >> 9, i9 = idp & 511, f = (i9 & 31) >> 2, tt = (i9 >> 5) * 4 + (i9 & 3);
        P = (const bf16_t*)(ws + (half == 0 ? OFF_WZ : OFF_WG)) + (size_t)f * 256 * 1024;
        Q = hb + (size_t)real_tile_row256(tt) * 1024;
        return true;
    };
    GSets gs;
    const bf16_t* Pn = nullptr; const bf16_t* Qn = nullptr;
    bool vn = tile_ptrs(0, Pn, Qn);
    if (vn) { int ti = tid; asm volatile("" : "+v"(ti)); gemm_issue(Pn, Qn, gs, ti); }
    for (int rb = 0; rb < 16 * 64; rb += per_round) {
        const int idp = rb + xcd * (per_round >> 3) + cu;
        const bool v = vn;
        const bf16_t* P = Pn; const bf16_t* Q = Qn;
        if (!v) { vn = tile_ptrs(rb + per_round, Pn, Qn); if (vn) { int ti = tid; asm volatile("" : "+v"(ti)); gemm_issue(Pn, Qn, gs, ti); } continue; }
        const int half = idp >> 9, i9 = idp & 511;
        const int f = (i9 & 31) >> 2, tt = (i9 >> 5) * 4 + (i9 & 3);
        const int r0 = real_tile_row256(tt);
        f32x16 acc[4][2];
        { int tl = tid; asm volatile("" : "+v"(tl));
          gemm_tile3p<4, 4>(P, 1024, Q, 1024, lds, acc, tl, gs); }
        vn = tile_ptrs(rb + per_round, Pn, Qn);
        if (vn) { int ti = tid; asm volatile("" : "+v"(ti)); gemm_issue(Pn, Qn, gs, ti); }
        int te = tid; asm volatile("" : "+v"(te));
        const int lane = te & 63, wid = te >> 6, wj = wid & 3, ln = lane & 31;
        float rsj[2];
#pragma unroll
        for (int jt = 0; jt < 2; ++jt) rsj[jt] = rstd[r0 + wj * 64 + jt * 32 + ln];
        if (half == 0) {
            bf16_t* obuf = (bf16_t*)(ws + (f < 4 ? OFF_QN : OFF_FQ)) + (f & 3) * 256;
            staged_rows_rmw<4, 4>(lds, te,
                [&](int it, int jt, int g) { const float sc = rsj[jt];
                    return pk4(fsilu(acc[it][jt][4 * g] * sc), fsilu(acc[it][jt][4 * g + 1] * sc), fsilu(acc[it][jt][4 * g + 2] * sc), fsilu(acc[it][jt][4 * g + 3] * sc)); },
                [&](int row, int col) { return *(const u32x4*)(obuf + (size_t)(r0 + row) * 1024 + col); },
                [&](int row, int col, u32x4 v, u32x4 o) { u32x4 w;
#pragma unroll
                    for (int e = 0; e < 4; ++e) w[e] = pk2(bf_lo(o[e]) * bf_lo(v[e]), bf_hi(o[e]) * bf_hi(v[e]));
                    *(u32x4*)(obuf + (size_t)(r0 + row) * 1024 + col) = w; });
        } else {
            unsigned char* gt = ws + OFF_G + ((size_t)(f * 64 + tt) * 8 + wid) * 16384 + lane * 16;
#pragma unroll
            for (int it = 0; it < 4; ++it)
#pragma unroll
                for (int jt = 0; jt < 2; ++jt)
#pragma unroll
                    for (int gp = 0; gp < 2; ++gp) {
                        const float sc = rsj[jt];
                        u32x4 w;
#pragma unroll
                        for (int e = 0; e < 4; ++e) w[e] = pk2(fsigmoid(acc[it][jt][8 * gp + 2 * e] * sc), fsigmoid(acc[it][jt][8 * gp + 2 * e + 1] * sc));
                        *(u32x4*)(gt + ((it * 2 + jt) * 2 + gp) * 1024) = w;
                    }
        }
    }
}

DI void phase4(const Params& p, unsigned char* smem, int tid) {
    unsigned char* ws = p.ws;
    unsigned char* lds = smem + LDS_MISC;
    bf16_t* mx = (bf16_t*)(ws + OFF_FK);
    const int xcd = blockIdx.x & 7, cu = blockIdx.x >> 3, per_round = gridDim.x;
    for (int rb = 0; rb < 4 * 64; rb += per_round) {
        const int idp = rb + xcd * (per_round >> 3) + cu;
        if (idp >= 4 * 64) continue;
        const int f = (idp & 31) >> 3, tt = (idp >> 5) * 8 + (idp & 7);
        const int r0 = real_tile_row256(tt);
        f32x16 acc[4][2];
        { int tl = tid; asm volatile("" : "+v"(tl));
          gemm_tile3r<4, 4>((const bf16_t*)(ws + OFF_WBM) + (size_t)f * 256 * 1024, 1024, (const bf16_t*)(ws + OFF_QN) + (size_t)r0 * 1024, 1024, 1024, lds, acc, tl); }
        {
            int te = tid; asm volatile("" : "+v"(te));
            const unsigned char* ga = ws + OFF_G + ((size_t)(f * 64 + tt) * 8 + (te >> 6)) * 16384 + (te & 63) * 16;
            const unsigned char* gb = ga + (size_t)4 * 64 * 8 * 16384;
#pragma unroll
            for (int it = 0; it < 4; ++it)
#pragma unroll
                for (int jt = 0; jt < 2; ++jt)
#pragma unroll
                    for (int gp = 0; gp < 2; ++gp) {
                        const u32x4 a4 = *(const u32x4*)(ga + ((it * 2 + jt) * 2 + gp) * 1024), b4 = *(const u32x4*)(gb + ((it * 2 + jt) * 2 + gp) * 1024);
#pragma unroll
                        for (int e = 0; e < 4; ++e) {
                            acc[it][jt][8 * gp + 2 * e] *= bf_lo(a4[e]) * __builtin_amdgcn_rcpf(fmaxf(bf_lo(b4[e]), 8.6736174e-19f));
                            acc[it][jt][8 * gp + 2 * e + 1] *= bf_hi(a4[e]) * __builtin_amdgcn_rcpf(fmaxf(bf_hi(b4[e]), 8.6736174e-19f));
                        }
                    }
        }
        { int tl = tid; asm volatile("" : "+v"(tl));
          gemm_tile3r<4, 4, 0, false>((const bf16_t*)(ws + OFF_WBF) + (size_t)f * 256 * 1024, 1024, (const bf16_t*)(ws + OFF_FQ) + (size_t)r0 * 1024, 1024, 1024, lds, acc, tl); }
        {
            int te = tid; asm volatile("" : "+v"(te));
            const unsigned char* gb = ws + OFF_G + ((size_t)((4 + f) * 64 + tt) * 8 + (te >> 6)) * 16384 + (te & 63) * 16;
            staged_rows<4, 4>(lds, te,
                [&](int it, int jt, int g) { const u32x4 b4 = *(const u32x4*)(gb + ((it * 2 + jt) * 2 + (g >> 1)) * 1024); const int e0 = (g & 1) * 2;
                    const float g0 = fmaxf(bf_lo(b4[e0]), 8.6736174e-19f), g1 = fmaxf(bf_hi(b4[e0]), 8.6736174e-19f);
                    const float g2 = fmaxf(bf_lo(b4[e0 + 1]), 8.6736174e-19f), g3 = fmaxf(bf_hi(b4[e0 + 1]), 8.6736174e-19f);
                    return pk4(acc[it][jt][4 * g] * g0, acc[it][jt][4 * g + 1] * g1, acc[it][jt][4 * g + 2] * g2, acc[it][jt][4 * g + 3] * g3); },
                [&](int row, int col, u32x4 v) { *(u32x4*)(mx + (size_t)(r0 + row) * 1024 + f * 256 + col) = v; });
        }
    }
}

DI void phase5(const Params& p, unsigned char* smem, int tid, bool coop) {
    unsigned char* ws = p.ws;
    unsigned char* lds = smem + LDS_MISC;
    const bf16_t* mx = (const bf16_t*)(ws + OFF_FK);
    float* ssq = (float*)(ws + OFF_SSQ);
    const bool fused = coop && gridDim.x == 256;
    const int xcd = blockIdx.x & 7, cu = blockIdx.x >> 3, per_round = gridDim.x;
    for (int rb = 0; rb < 4 * 64; rb += per_round) {
        const int idp = rb + xcd * (per_round >> 3) + cu;
        if (idp >= 4 * 64) continue;
        const int f = (idp & 31) >> 3, tt = (idp >> 5) * 8 + (idp & 7);
        const int r0 = real_tile_row256(tt);
        f32x16 acc[4][2];
        int tl = tid; asm volatile("" : "+v"(tl));
        gemm_tile3r<4, 4>((const bf16_t*)(ws + OFF_WOUT) + (size_t)f * 256 * 1024, 1024, mx + (size_t)r0 * 1024, 1024, 1024, lds, acc, tl);
        int te = tid; asm volatile("" : "+v"(te));
        const int lane = te & 63, wid = te >> 6, wi = wid >> 2, wj = wid & 3, h = lane >> 5, ln = lane & 31;
#pragma unroll
        for (int jt = 0; jt < 2; ++jt) {
            const int tr = tt * 256 + wj * 64 + jt * 32 + ln;
            float sq = 0.f;
#pragma unroll
            for (int it = 0; it < 4; ++it)
#pragma unroll
                for (int r = 0; r < 16; ++r) sq += acc[it][jt][r] * acc[it][jt][r];
            { const auto sw = __builtin_amdgcn_permlane32_swap(__float_as_uint(sq), __float_as_uint(sq), false, false);
              sq = __uint_as_float(sw[0]) + __uint_as_float(sw[1]); }
            if (h == 0) atomicAdd(ssq + tr, sq);
        }
        if (fused) {
            unsigned* cnt = (unsigned*)(ws + OFF_CTRL) + 128 + tt;
            unsigned* bar = (unsigned*)(ws + OFF_BAR);
            asm volatile("s_waitcnt vmcnt(0)" ::: "memory");
            __syncthreads();
            if (te == 0) {
                __builtin_amdgcn_fence(__ATOMIC_RELEASE, "agent");
                (void)xb_add(cnt, 1u);
                XB_SPIN(xb_ld(cnt) < 4u, bar);
                __builtin_amdgcn_fence(__ATOMIC_ACQUIRE, "agent");
            }
            __syncthreads();
            float rsj[2];
#pragma unroll
            for (int jt = 0; jt < 2; ++jt)
                rsj[jt] = 1.0f / sqrtf(__hip_atomic_load(ssq + tt * 256 + wj * 64 + jt * 32 + ln, __ATOMIC_RELAXED, __HIP_MEMORY_SCOPE_AGENT) * (1.0f / D) + EPS);
            staged_rows_rmw<4, 4>(lds, te,
                [&](int it, int jt, int g) { const f32x4 gv = *(const f32x4*)(p.post_g + f * 256 + wi * 128 + it * 32 + 8 * g + 4 * h); const float rs = rsj[jt];
                    return pk4(acc[it][jt][4 * g] * rs * gv[0], acc[it][jt][4 * g + 1] * rs * gv[1], acc[it][jt][4 * g + 2] * rs * gv[2], acc[it][jt][4 * g + 3] * rs * gv[3]); },
                [&](int row, int col) { const size_t o = (size_t)(tt * 256 + row) * 1024 + f * 256 + col; X8 r; r.a = *(const f32x4*)(p.x + o); r.b = *(const f32x4*)(p.x + o + 4); return r; },
                [&](int row, int col, u32x4 v, X8 xv) { const size_t o = (size_t)(tt * 256 + row) * 1024 + f * 256 + col;
                    *(f32x4*)(p.out + o) = (f32x4){xv.a[0] + bf_lo(v[0]), xv.a[1] + bf_hi(v[0]), xv.a[2] + bf_lo(v[1]), xv.a[3] + bf_hi(v[1])};
                    *(f32x4*)(p.out + o + 4) = (f32x4){xv.b[0] + bf_lo(v[2]), xv.b[1] + bf_hi(v[2]), xv.b[2] + bf_lo(v[3]), xv.b[3] + bf_hi(v[3])}; });
        } else {
#pragma unroll
            for (int jt = 0; jt < 2; ++jt) {
                const int tr = tt * 256 + wj * 64 + jt * 32 + ln;
#pragma unroll
                for (int it = 0; it < 4; ++it) {
                    float* dst = p.out + (size_t)tr * 1024 + f * 256 + wi * 128 + it * 32;
#pragma unroll
                    for (int g = 0; g < 4; ++g)
                        *(f32x4*)(dst + 8 * g + 4 * h) = (f32x4){acc[it][jt][4 * g], acc[it][jt][4 * g + 1], acc[it][jt][4 * g + 2], acc[it][jt][4 * g + 3]};
                }
            }
        }
    }
}

DI void phase6(const Params& p, int tid) {
    const float* ssq = (const float*)(p.ws + OFF_SSQ);
    const int gsz = gridDim.x * NT;
    for (int i = blockIdx.x * NT + tid; i < NB * S * (D / 4); i += gsz) {
        const int tr = i >> 8, c = (i & 255) * 4;
        const float rs = 1.0f / sqrtf(ssq[tr] * (1.0f / D) + EPS);
        const f32x4 mv = *(const f32x4*)(p.out + (size_t)i * 4);
        const f32x4 xv = *(const f32x4*)(p.x + (size_t)i * 4);
        const f32x4 g = *(const f32x4*)(p.post_g + c);
        *(f32x4*)(p.out + (size_t)i * 4) = (f32x4){xv[0] + mv[0] * rs * g[0], xv[1] + mv[1] * rs * g[1], xv[2] + mv[2] * rs * g[2], xv[3] + mv[3] * rs * g[3]};
    }
}

template <bool COOP>
__global__ void __launch_bounds__(NT) mega(Params p, int lo, int hi) {
    extern __shared__ __attribute__((aligned(16))) unsigned char smem[];
    const int wave_s = __builtin_amdgcn_readfirstlane((int)threadIdx.x >> 6);
#define TID0 ([&]() __attribute__((always_inline)) { unsigned z_ = 0u; asm volatile("" : "+s"(z_)); return (wave_s << 6) | (int)__builtin_amdgcn_mbcnt_hi(~0u, __builtin_amdgcn_mbcnt_lo(~0u, z_)); }())
    volatile LAS unsigned* xst = (volatile LAS unsigned*)(smem + 1024);
    XcdBarrier xb; xb.bar = (unsigned*)(p.ws + OFF_BAR); xb.x = 0u; xb.st = xst;
    if (COOP) {
        if (hi < lo) cg::this_grid().sync();
        { const int t0_ = TID0; if (t0_ < 4) xst[t0_] = 0u; }
        __syncthreads();
        xb = xcd_barrier_post((unsigned*)(p.ws + OFF_BAR), xst);
    }
#define SEAM(n) if (COOP && (n) < hi) { xcd_barrier(xb); }
#define PHASE(n, call) if (lo <= (n) && (n) <= hi) { int tid = TID0; asm volatile("" : "+v"(tid)); call; SEAM(n) }
    PHASE(0, phase0(p, smem, tid))
#if PROBE_DUP & 1
    PHASE(0, phase0(p, smem, tid))
#endif
#if PROBE_DUP & 64
    if (COOP) { for (int i_ = 0; i_ < 10; ++i_) xcd_barrier(xb); }
#endif
#if PROBE_DUP & 2
    PHASE(1, phase1<PROBE_MODE>(p, smem, tid))
#endif
    PHASE(1, phase1<0>(p, smem, tid))
    PHASE(2, phase2(p, smem, tid))
#if PROBE_DUP & 4
    PHASE(2, phase2(p, smem, tid))
#endif
    PHASE(3, phase3(p, smem, tid, 0))
#if PROBE_DUP & 8
    PHASE(1, phase1<0>(p, smem, tid))
    PHASE(2, phase2(p, smem, tid))
    PHASE(3, phase3(p, smem, tid, 1))
#endif
    PHASE(4, phase3b(p, smem, tid))
    PHASE(5, phase4(p, smem, tid))
#if PROBE_DUP & 32
    PHASE(5, phase4(p, smem, tid))
#endif
    if (lo <= 6 && 6 <= hi) { int tid = TID0; asm volatile("" : "+v"(tid)); phase5(p, smem, tid, COOP); if (COOP && 6 < hi && gridDim.x != 256) xcd_barrier(xb); }
    if (lo <= 7 && 7 <= hi && (!COOP || gridDim.x != 256)) { int tid = TID0; asm volatile("" : "+v"(tid)); phase6(p, tid); }
#undef PHASE
#undef SEAM
}

extern "C" void kernel_launch(void* const* d_in, const int* in_sizes, int n_in, void* d_out, int out_size, void* d_ws, size_t ws_size,
                              hipStream_t stream) {
    static int grid = 0;
    if (grid == 0) {
        if (n_in != 13 || out_size != NB * S * D || ws_size < WS_END) {
            fprintf(stderr, "kernel_launch: unexpected shapes: n_in %d out %d ws %zu (need %zu)\n", n_in, out_size, ws_size, (size_t)WS_END);
            grid = -1; return;
        }
        int dev = 0, cus = 0, per_cu = 0;
        (void)hipGetDevice(&dev);
        (void)hipDeviceGetAttribute(&cus, hipDeviceAttributeMultiprocessorCount, dev);
#if MK_LAUNCHES == 1
        const void* fn = (const void*)mega<true>;
#else
        const void* fn = (const void*)mega<false>;
#endif
        if (hipFuncSetAttribute(fn, hipFuncAttributeMaxDynamicSharedMemorySize, LDS_BYTES) != hipSuccess) { fprintf(stderr, "kernel_launch: hipFuncSetAttribute failed\n"); grid = -1; return; }
        if (hipOccupancyMaxActiveBlocksPerMultiprocessor(&per_cu, fn, NT, LDS_BYTES) != hipSuccess || per_cu < 1) { fprintf(stderr, "kernel_launch: occupancy query failed (%d)\n", per_cu); grid = -1; return; }
        grid = cus * 1;
    }
    if (grid < 0) return;
    Params p{};
    p.x = (const float*)d_in[0]; p.meta = (const float*)d_in[1]; p.pre_g = (const float*)d_in[2]; p.w_in = (const float*)d_in[3];
    p.fox_b = (const float*)d_in[4]; p.qn_g = (const float*)d_in[5]; p.kvn_g = (const float*)d_in[6]; p.w_uq = (const float*)d_in[7];
    p.w_ukv = (const float*)d_in[8]; p.w_bm = (const float*)d_in[9]; p.w_bf = (const float*)d_in[10]; p.w_out = (const float*)d_in[11];
    p.post_g = (const float*)d_in[12];
    p.out = (float*)d_out; p.ws = (unsigned char*)d_ws;
#if MK_LAUNCHES == 1
    if (hipMemsetAsync((unsigned char*)d_ws + OFF_BAR, 0, XCD_BAR_WORDS * 4, stream) != hipSuccess) { fprintf(stderr, "kernel_launch: memset of the barrier words failed\n"); return; }
    int lo = 0, hi = 7;
    void* args[] = {&p, &lo, &hi};
    hipError_t e = hipLaunchCooperativeKernel((const void*)mega<true>, dim3(grid), dim3(NT), args, LDS_BYTES, stream);
    if (e != hipSuccess) fprintf(stderr, "cooperative launch failed: %s (grid %d)\n", hipGetErrorString(e), grid);
#else
    for (int ph = 0; ph <= 7; ++ph) hipLaunchKernelGGL(mega<false>, dim3(grid), dim3(NT), LDS_BYTES, stream, p, ph, ph);
#endif
}
```

```cpp
#include <hip/hip_runtime.h>
#include <hip/hip_cooperative_groups.h>
#include <cstdio>
#include <cstdint>
namespace cg = cooperative_groups;

#ifndef MK_LAUNCHES
#define MK_LAUNCHES 1
#endif
#ifndef PROBE_DUP
#define PROBE_DUP 0
#endif
#ifndef PROBE_MODE
#define PROBE_MODE 0
#endif

typedef unsigned short bf16_t;
typedef short bf16x8 __attribute__((ext_vector_type(8)));
typedef short s16x4 __attribute__((ext_vector_type(4)));
typedef float f32x16 __attribute__((ext_vector_type(16)));
typedef float f32x4 __attribute__((ext_vector_type(4)));
typedef float f32x2 __attribute__((ext_vector_type(2)));
typedef unsigned u32x4 __attribute__((ext_vector_type(4)));
typedef unsigned u32x2 __attribute__((ext_vector_type(2)));
typedef __bf16 bf2_t __attribute__((ext_vector_type(2)));

#define DI __device__ __forceinline__

constexpr int NT = 512;
constexpr int D = 1024, NB = 4, S = 4096, NMETA = 16, L = S + NMETA, T = NB * L;
constexpr int TP = 16640, LP = 4160, NH = 16;
constexpr float EPS = 1e-6f;
constexpr float LOG2E = 1.4426950408889634f;
constexpr float MLA_QS = (float)(1.4426950408889634 / 9.797958971132712);
constexpr float FOX_QS = (float)(1.4426950408889634 / 8.0);

constexpr size_t al256(size_t x) { return (x + 255) & ~(size_t)255; }
constexpr size_t OFF_CTRL = 0;
constexpr size_t OFF_BAR = 4096;
constexpr size_t OFF_SSQ = OFF_BAR + 16384;
constexpr size_t OFF_RSTD0 = OFF_SSQ + (size_t)NB * S * 4;
constexpr size_t OFF_ROPE = OFF_RSTD0 + al256((size_t)TP * 4);
constexpr size_t OFF_BIAS = OFF_ROPE + al256((size_t)LP * 32 * 4);
constexpr size_t OFF_FLOGIT = OFF_BIAS + al256((size_t)NB * NH * LP * 4);
constexpr size_t OFF_SSQC = OFF_FLOGIT + al256((size_t)TP * 16 * 4);
constexpr size_t OFF_RKV = OFF_SSQC + al256((size_t)TP * 4);
constexpr size_t OFF_WT1 = OFF_RKV + al256((size_t)TP * 4);
constexpr size_t OFF_WZ = OFF_WT1 + (size_t)3584 * 1024 * 2;
constexpr size_t OFF_WG = OFF_WZ + (size_t)2048 * 1024 * 2;
constexpr size_t OFF_WUQ = OFF_WG + (size_t)2048 * 1024 * 2;
constexpr size_t OFF_WUKV = OFF_WUQ + (size_t)1536 * 256 * 2;
constexpr size_t OFF_WBM = OFF_WUKV + (size_t)2048 * 128 * 2;
constexpr size_t OFF_WBF = OFF_WBM + (size_t)1024 * 1024 * 2;
constexpr size_t OFF_WOUT = OFF_WBF + (size_t)1024 * 1024 * 2;
constexpr size_t OFF_HB = OFF_WOUT + (size_t)1024 * 1024 * 2;
constexpr size_t OFF_FQ = OFF_HB + (size_t)TP * 1024 * 2;
constexpr size_t OFF_FK = OFF_FQ + (size_t)TP * 1024 * 2;
constexpr size_t OFF_QN = OFF_FK + (size_t)TP * 1024 * 2;
constexpr size_t OFF_QPE = OFF_QN + (size_t)TP * 1024 * 2;
constexpr size_t OFF_FVT = OFF_QPE + (size_t)TP * 512 * 2;
constexpr size_t OFF_VMT = OFF_FVT + (size_t)NB * NH * 64 * LP * 2;
constexpr size_t WS_END = OFF_VMT + (size_t)NB * NH * 64 * LP * 2;
static_assert(WS_END <= ((size_t)256 << 20), "workspace too large");
constexpr size_t OUT_KM = 0;
constexpr size_t OUT_CQ = OUT_KM + (size_t)TP * 1536 * 2;
constexpr size_t OUT_CKV = OUT_CQ + (size_t)TP * 256 * 2;
constexpr size_t OUT_KPE = OUT_CKV + (size_t)TP * 128 * 2;
static_assert(OUT_KPE + (size_t)TP * 32 * 4 <= (size_t)NB * S * D * 4, "d_out scratch too large");

struct Params {
    const float *x, *meta, *pre_g, *w_in, *fox_b, *qn_g, *kvn_g, *w_uq, *w_ukv, *w_bm, *w_bf, *w_out, *post_g;
    float* out;
    unsigned char* ws;
};

DI unsigned pk2(float lo, float hi) { f32x2 v = {lo, hi}; bf2_t b = __builtin_convertvector(v, bf2_t); return __builtin_bit_cast(unsigned, b); }
DI u32x2 pk4(float a, float b, float c, float d) { u32x2 r; r.x = pk2(a, b); r.y = pk2(c, d); return r; }
DI float bf_lo(unsigned u) { return __uint_as_float(u << 16); }
DI float bf_hi(unsigned u) { return __uint_as_float(u & 0xffff0000u); }
DI float fsigmoid(float z) { return __builtin_amdgcn_rcpf(1.0f + __expf(-z)); }
DI float fsilu(float z) { return z * fsigmoid(z); }
DI int crow(int r, int h) { return (r & 3) + 8 * (r >> 2) + 4 * h; }

#define XB_TMO      128
#define XB_XCNT(j)  (256  + 64 * (j))
#define XB_XSUB(j)  (1280 + 64 * (j))
#define XB_XGEN(j)  (2304 + 64 * (j))
#define XB_TOP      3328
#define XB_TOPGEN   3392
#define XCD_BAR_WORDS 3456
#define XB_SPIN_CAP (1u << 18)
#define LAS __attribute__((address_space(3)))
DI unsigned xb_ld(unsigned* p) { return __hip_atomic_load(p, __ATOMIC_RELAXED, __HIP_MEMORY_SCOPE_AGENT); }
DI unsigned xb_add(unsigned* p, unsigned v) { return __hip_atomic_fetch_add(p, v, __ATOMIC_RELAXED, __HIP_MEMORY_SCOPE_AGENT); }
DI unsigned xb_xcc_id() { return (unsigned)__builtin_amdgcn_s_getreg((3 << 11) | 20) & 0xFu; }
#define XB_SPIN(cond, bar) do { unsigned _sp = 0; while (cond) { __builtin_amdgcn_s_sleep(1); \
    if ((++_sp & 255u) == 0u) { if (xb_ld(&(bar)[XB_TMO])) break; if (_sp > XB_SPIN_CAP) { atomicAdd(&(bar)[XB_TMO], 1u); break; } } } } while (0)
struct XcdBarrier { unsigned* bar; unsigned x; volatile LAS unsigned* st; };
DI XcdBarrier xcd_barrier_post(unsigned* bar, volatile LAS unsigned* st) {
    XcdBarrier b; b.bar = bar; b.x = xb_xcc_id(); b.st = st;
    if (threadIdx.x == 0) (void)xb_add(&bar[XB_XCNT(b.x)], 1u);
    return b;
}
DI void xcd_barrier_complete(unsigned* bar, unsigned x, unsigned& nloc, unsigned& nx) {
    const unsigned G = gridDim.x * gridDim.y * gridDim.z;
    unsigned sum, cnt, mine, sp = 0u;
    for (;;) {
        sum = 0u; cnt = 0u; mine = 0u;
#pragma unroll
        for (unsigned j = 0; j < 16; ++j) { const unsigned c = xb_ld(&bar[XB_XCNT(j)]); sum += c; cnt += (c > 0u) ? 1u : 0u; mine = (j == x) ? c : mine; }
        if (sum == G) break;
        __builtin_amdgcn_s_sleep(1);
        if ((++sp & 255u) == 0u) { if (xb_ld(&bar[XB_TMO])) break; if (sp > XB_SPIN_CAP) { atomicAdd(&bar[XB_TMO], 1u); break; } }
    }
    nloc = mine > 0u ? mine : 1u; nx = cnt > 0u ? cnt : 1u;
}
DI void xcd_barrier(const XcdBarrier& b) {
    asm volatile("s_waitcnt vmcnt(0)" ::: "memory");
    __syncthreads();
    if (threadIdx.x == 0) {
        unsigned* bar = b.bar;
        __builtin_amdgcn_s_waitcnt(0);
        unsigned nloc = b.st[0], nx = b.st[1];
        if (nloc == 0u) { xcd_barrier_complete(bar, b.x, nloc, nx); b.st[0] = nloc; b.st[1] = nx; }
        const unsigned old = xb_add(&bar[XB_XSUB(b.x)], 1u);
        const unsigned gen = old / nloc;
        if (old + 1u == (gen + 1u) * nloc) {
            __builtin_amdgcn_fence(__ATOMIC_RELEASE, "agent");
            asm volatile("s_waitcnt vmcnt(0)" ::: "memory");
            const unsigned og = xb_add(&bar[XB_TOP], 1u);
            const unsigned tg = og / nx;
            if (og + 1u == (tg + 1u) * nx) xb_add(&bar[XB_TOPGEN], 1u);
            else XB_SPIN(xb_ld(&bar[XB_TOPGEN]) == tg, bar);
            __builtin_amdgcn_fence(__ATOMIC_ACQUIRE, "agent");
            xb_add(&bar[XB_XGEN(b.x)], 1u);
            asm volatile("s_waitcnt vmcnt(0)" ::: "memory");
        } else {
            XB_SPIN(xb_ld(&bar[XB_XGEN(b.x)]) == gen, bar);
            __builtin_amdgcn_fence(__ATOMIC_ACQUIRE, "agent");
            asm volatile("s_waitcnt vmcnt(0)" ::: "memory");
        }
    }
    __syncthreads();
}

constexpr int BK = 32, LROW = 80;
constexpr int LDS_MISC = 2048;
template <int WI, int WGJ> struct GC {
    static constexpr int WGI = 8 / WGJ, BI = WGI * WI * 32, BJ = WGJ * 64, STAGE = (BI + BJ) * LROW, NP = BI * 4 / NT, NQ = BJ * 4 / NT;
};
constexpr int LDS_BYTES = LDS_MISC + 3 * GC<4, 4>::STAGE;

template <int WI, int WGJ, int MODE = 0>
DI void gemm_tile2(const bf16_t* __restrict__ P, int ldp, const bf16_t* __restrict__ Q, int ldq, int K,
                  unsigned char* lds, f32x16 (&acc)[WI][2], int tid) {
    typedef GC<WI, WGJ> C;
    constexpr int NP = C::NP, NQ = C::NQ, STAGE = C::STAGE, BI = C::BI;
    const int lane = tid & 63, wid = tid >> 6, wi = wid / WGJ, wj = wid % WGJ;
    const int lrow = tid >> 2, lch = tid & 3;
    const bf16_t* pp = P + (size_t)lrow * ldp + lch * 8;
    const bf16_t* qp = Q + (size_t)lrow * ldq + lch * 8;
    unsigned char* wP = lds + lrow * LROW + lch * 16;
    const unsigned char* rP = lds + (wi * WI * 32 + (lane & 31)) * LROW + (lane >> 5) * 16;
    const unsigned char* rQ = lds + BI * LROW + (wj * 64 + (lane & 31)) * LROW + (lane >> 5) * 16;
    u32x4 pa[NP], qa[NQ], pb[NP], qb[NQ];
    bf16x8 fa0[WI], fb0[2], fa1[WI], fb1[2];
#pragma unroll
    for (int it = 0; it < WI; ++it)
#pragma unroll
        for (int jt = 0; jt < 2; ++jt)
#pragma unroll
            for (int r = 0; r < 16; ++r) acc[it][jt][r] = 0.f;
    const int nk = K / BK;
#define G_LOAD(pr, qr, kt_) if (MODE != 1) { _Pragma("unroll") for (int r = 0; r < NP; ++r) pr[r] = *(const u32x4*)(pp + (size_t)(r * 128) * ldp + (kt_) * BK); \
                              _Pragma("unroll") for (int r = 0; r < NQ; ++r) qr[r] = *(const u32x4*)(qp + (size_t)(r * 128) * ldq + (kt_) * BK); }
#define G_STORE(pr, qr, so_) { unsigned char* w_ = wP + (so_); \
                              _Pragma("unroll") for (int r = 0; r < NP; ++r) *(u32x4*)(w_ + r * 128 * LROW) = pr[r]; \
                              _Pragma("unroll") for (int r = 0; r < NQ; ++r) *(u32x4*)(w_ + BI * LROW + r * 128 * LROW) = qr[r]; }
#define F_LOAD(fa, fb, so_, ks_) { _Pragma("unroll") for (int it = 0; it < WI; ++it) fa[it] = *(const bf16x8*)(rP + (so_) + it * 32 * LROW + (ks_) * 32); \
                                  _Pragma("unroll") for (int jt = 0; jt < 2; ++jt) fb[jt] = *(const bf16x8*)(rQ + (so_) + jt * 32 * LROW + (ks_) * 32); }
#define G_MFMA(fa, fb) if (MODE != 2) { _Pragma("unroll") for (int it = 0; it < WI; ++it) _Pragma("unroll") for (int jt = 0; jt < 2; ++jt) \
                            acc[it][jt] = __builtin_amdgcn_mfma_f32_32x32x16_bf16(fa[it], fb[jt], acc[it][jt], 0, 0, 0); }
#define SB __builtin_amdgcn_sched_barrier(0);
    if (MODE == 1) {
#pragma unroll
        for (int r = 0; r < NP; ++r) { pa[r] = *(const u32x4*)(pp + (size_t)(r * 128) * ldp); pb[r] = pa[r]; }
#pragma unroll
        for (int r = 0; r < NQ; ++r) { qa[r] = *(const u32x4*)(qp + (size_t)(r * 128) * ldq); qb[r] = qa[r]; }
    }
    G_LOAD(pa, qa, 0)
    G_LOAD(pb, qb, 1)
    G_STORE(pa, qa, 0)
    G_LOAD(pa, qa, 2)
    G_STORE(pb, qb, STAGE)
    __syncthreads();
    F_LOAD(fa0, fb0, 0, 0)
    int cur = 0, nxt = STAGE, wr = 2 * STAGE;
#pragma unroll 1
    for (int kt = 0; kt < nk; kt += 2) {
        const int k3 = min(kt + 3, nk - 1), k4 = min(kt + 4, nk - 1);
        SB
        G_LOAD(pb, qb, k3)
        F_LOAD(fa1, fb1, cur, 1)
        SB
        G_MFMA(fa0, fb0)
        SB
        G_STORE(pa, qa, wr)
        F_LOAD(fa0, fb0, nxt, 0)
        SB
        G_MFMA(fa1, fb1)
        SB
        __syncthreads();
        { const int t_ = cur; cur = nxt; nxt = wr; wr = t_; }
        SB
        G_LOAD(pa, qa, k4)
        F_LOAD(fa1, fb1, cur, 1)
        SB
        G_MFMA(fa0, fb0)
        SB
        G_STORE(pb, qb, wr)
        F_LOAD(fa0, fb0, nxt, 0)
        SB
        G_MFMA(fa1, fb1)
        SB
        __syncthreads();
        { const int t_ = cur; cur = nxt; nxt = wr; wr = t_; }
    }
#undef G_LOAD
#undef G_STORE
#undef F_LOAD
#undef G_MFMA
#undef SB
}

template <int WI, int WGJ, int MODE = 0>
DI void gemm_tile3(const bf16_t* __restrict__ P, int ldp, const bf16_t* __restrict__ Q, int ldq, int K,
                  unsigned char* lds, f32x16 (&acc)[WI][2], int tid) {
    typedef GC<WI, WGJ> C;
    constexpr int NP = C::NP, NQ = C::NQ, STAGE = C::STAGE, BI = C::BI;
    const int lane = tid & 63, wid = tid >> 6, wi = wid / WGJ, wj = wid % WGJ;
    const int lrow = tid >> 2, lch = tid & 3;
    const bf16_t* pp = P + (size_t)lrow * ldp + lch * 8;
    const bf16_t* qp = Q + (size_t)lrow * ldq + lch * 8;
    unsigned char* wP = lds + lrow * LROW + lch * 16;
    const unsigned char* rP = lds + (wi * WI * 32 + (lane & 31)) * LROW + (lane >> 5) * 16;
    const unsigned char* rQ = lds + BI * LROW + (wj * 64 + (lane & 31)) * LROW + (lane >> 5) * 16;
    u32x4 p0[NP], q0[NQ], p1[NP], q1[NQ], p2[NP], q2[NQ];
    bf16x8 fa0[WI], fb0[2], fa1[WI], fb1[2];
#pragma unroll
    for (int it = 0; it < WI; ++it)
#pragma unroll
        for (int jt = 0; jt < 2; ++jt)
#pragma unroll
            for (int r = 0; r < 16; ++r) acc[it][jt][r] = 0.f;
    const int nk = K / BK;
#define G_LOAD(pr, qr, kt_) if (MODE != 1) { _Pragma("unroll") for (int r = 0; r < NP; ++r) pr[r] = *(const u32x4*)(pp + (size_t)(r * 128) * ldp + (kt_) * BK); \
                              _Pragma("unroll") for (int r = 0; r < NQ; ++r) qr[r] = *(const u32x4*)(qp + (size_t)(r * 128) * ldq + (kt_) * BK); }
#define G_STORE(pr, qr, so_) { unsigned char* w_ = wP + (so_); \
                              _Pragma("unroll") for (int r = 0; r < NP; ++r) *(u32x4*)(w_ + r * 128 * LROW) = pr[r]; \
                              _Pragma("unroll") for (int r = 0; r < NQ; ++r) *(u32x4*)(w_ + BI * LROW + r * 128 * LROW) = qr[r]; }
#define F_LOAD(fa, fb, so_, ks_) { _Pragma("unroll") for (int it = 0; it < WI; ++it) fa[it] = *(const bf16x8*)(rP + (so_) + it * 32 * LROW + (ks_) * 32); \
                                  _Pragma("unroll") for (int jt = 0; jt < 2; ++jt) fb[jt] = *(const bf16x8*)(rQ + (so_) + jt * 32 * LROW + (ks_) * 32); }
#define G_MFMA(fa, fb) if (MODE != 2) { _Pragma("unroll") for (int it = 0; it < WI; ++it) _Pragma("unroll") for (int jt = 0; jt < 2; ++jt) \
                            acc[it][jt] = __builtin_amdgcn_mfma_f32_32x32x16_bf16(fa[it], fb[jt], acc[it][jt], 0, 0, 0); }
#define SB __builtin_amdgcn_sched_barrier(0);
#define G_HALF(pl, ql, ps, qs, kt_) { const int k4_ = min((kt_) + 4, nk - 1); \
        SB G_LOAD(pl, ql, k4_) F_LOAD(fa1, fb1, cur, 1) SB G_MFMA(fa0, fb0) SB G_STORE(ps, qs, wr) F_LOAD(fa0, fb0, nxt, 0) SB G_MFMA(fa1, fb1) SB \
        __syncthreads(); { const int t_ = cur; cur = nxt; nxt = wr; wr = t_; } }
    if (MODE == 1) {
#pragma unroll
        for (int r = 0; r < NP; ++r) { p0[r] = *(const u32x4*)(pp + (size_t)(r * 128) * ldp); p1[r] = p0[r]; p2[r] = p0[r]; }
#pragma unroll
        for (int r = 0; r < NQ; ++r) { q0[r] = *(const u32x4*)(qp + (size_t)(r * 128) * ldq); q1[r] = q0[r]; q2[r] = q0[r]; }
    }
    G_LOAD(p0, q0, 0)
    G_LOAD(p1, q1, 1)
    G_LOAD(p2, q2, 2)
    G_STORE(p0, q0, 0)
    G_LOAD(p0, q0, 3)
    G_STORE(p1, q1, STAGE)
    __syncthreads();
    F_LOAD(fa0, fb0, 0, 0)
    int cur = 0, nxt = STAGE, wr = 2 * STAGE;
    int kt = 0;
#pragma unroll 1
    for (; kt + 3 <= nk; kt += 3) {
        G_HALF(p1, q1, p2, q2, kt)
        G_HALF(p2, q2, p0, q0, kt + 1)
        G_HALF(p0, q0, p1, q1, kt + 2)
    }
    if (kt < nk) G_HALF(p1, q1, p2, q2, kt)
    if (kt + 1 < nk) G_HALF(p2, q2, p0, q0, kt + 1)
#undef G_HALF
#undef G_LOAD
#undef G_STORE
#undef F_LOAD
#undef G_MFMA
#undef SB
}

template <int WI, int WGJ, int MODE = 0, bool ZERO = true>
DI void gemm_tile3r(const bf16_t* __restrict__ P, int ldp, const bf16_t* __restrict__ Q, int ldq, int K,
                  unsigned char* lds, f32x16 (&acc)[WI][2], int tid) {
    typedef GC<WI, WGJ> C;
    constexpr int NP = C::NP, NQ = C::NQ, STAGE = C::STAGE, BI = C::BI;
    const int lane = tid & 63, wid = tid >> 6, wi = wid / WGJ, wj = wid % WGJ;
    const int lrow = tid >> 2, lch = tid & 3;
    const bf16_t* pp = P + (size_t)lrow * ldp + lch * 8;
    const bf16_t* qp = Q + (size_t)lrow * ldq + lch * 8;
    unsigned char* wP = lds + lrow * LROW + lch * 16;
    const unsigned char* rP = lds + (wi * WI * 32 + (lane & 31)) * LROW + (lane >> 5) * 16;
    const unsigned char* rQ = lds + BI * LROW + (wj * 64 + (lane & 31)) * LROW + (lane >> 5) * 16;
    u32x4 p0[NP], q0[NQ], p1[NP], q1[NQ], p2[NP], q2[NQ];
    bf16x8 fa0[WI], fb0[2], fb1[2];
    if (ZERO) {
#pragma unroll
        for (int it = 0; it < WI; ++it)
#pragma unroll
            for (int jt = 0; jt < 2; ++jt)
#pragma unroll
                for (int r = 0; r < 16; ++r) acc[it][jt][r] = 0.f;
    }
    const int nk = K / BK;
#define G_LOAD(pr, qr, kt_) if (MODE != 1) { _Pragma("unroll") for (int r = 0; r < NP; ++r) pr[r] = *(const u32x4*)(pp + (size_t)(r * 128) * ldp + (kt_) * BK); \
                              _Pragma("unroll") for (int r = 0; r < NQ; ++r) qr[r] = *(const u32x4*)(qp + (size_t)(r * 128) * ldq + (kt_) * BK); }
#define G_STORE(pr, qr, so_) { unsigned char* w_ = wP + (so_); \
                              _Pragma("unroll") for (int r = 0; r < NP; ++r) *(u32x4*)(w_ + r * 128 * LROW) = pr[r]; \
                              _Pragma("unroll") for (int r = 0; r < NQ; ++r) *(u32x4*)(w_ + BI * LROW + r * 128 * LROW) = qr[r]; }
#define F_LOAD(fa, fb, so_, ks_) { _Pragma("unroll") for (int it = 0; it < WI; ++it) fa[it] = *(const bf16x8*)(rP + (so_) + it * 32 * LROW + (ks_) * 32); \
                                  _Pragma("unroll") for (int jt = 0; jt < 2; ++jt) fb[jt] = *(const bf16x8*)(rQ + (so_) + jt * 32 * LROW + (ks_) * 32); }
#define G_MFMA(fa, fb) if (MODE != 2) { _Pragma("unroll") for (int it = 0; it < WI; ++it) _Pragma("unroll") for (int jt = 0; jt < 2; ++jt) \
                            acc[it][jt] = __builtin_amdgcn_mfma_f32_32x32x16_bf16(fa[it], fb[jt], acc[it][jt], 0, 0, 0); }
#define SB __builtin_amdgcn_sched_barrier(0);
#define A_LD(it_, so_, ks_) fa0[it_] = *(const bf16x8*)(rP + (so_) + (it_) * 32 * LROW + (ks_) * 32);
#define B_LD(fb, so_, ks_) { _Pragma("unroll") for (int jt = 0; jt < 2; ++jt) fb[jt] = *(const bf16x8*)(rQ + (so_) + jt * 32 * LROW + (ks_) * 32); }
#define X_LOAD(it_, pl, ql, kt_) if (MODE != 1) { if ((it_) < NP) pl[(it_) < NP ? (it_) : 0] = *(const u32x4*)(pp + (size_t)(((it_) < NP ? (it_) : 0) * 128) * ldp + (kt_) * BK); \
                                  else ql[(it_) >= NP ? (it_) - NP : 0] = *(const u32x4*)(qp + (size_t)(((it_) >= NP ? (it_) - NP : 0) * 128) * ldq + (kt_) * BK); }
#define X_STORE(it_, ps, qs, so_) { if ((it_) < NP) *(u32x4*)(wP + (so_) + ((it_) < NP ? (it_) : 0) * 128 * LROW) = ps[(it_) < NP ? (it_) : 0]; \
                                   else *(u32x4*)(wP + (so_) + BI * LROW + ((it_) >= NP ? (it_) - NP : 0) * 128 * LROW) = qs[(it_) >= NP ? (it_) - NP : 0]; }
#define B_LD1(fbn, jt_, so_, ks_) fbn[jt_] = *(const bf16x8*)(rQ + (so_) + (jt_) * 32 * LROW + (ks_) * 32);
#define R_BURST1(fb, fbn, so_, ks_, pl, ql, kt_, ps, qs, wo_) { _Pragma("unroll") for (int it = 0; it < WI; ++it) { \
            acc[it][0] = __builtin_amdgcn_mfma_f32_32x32x16_bf16(fa0[it], fb[0], acc[it][0], 0, 0, 0); SB \
            if (it < 2) B_LD1(fbn, it < 2 ? it : 0, so_, ks_) X_STORE(it, ps, qs, wo_) SB \
            acc[it][1] = __builtin_amdgcn_mfma_f32_32x32x16_bf16(fa0[it], fb[1], acc[it][1], 0, 0, 0); SB A_LD(it, so_, ks_) X_LOAD(it, pl, ql, kt_) SB } }
#define R_BURST2(fb, fbn, so_, ks_, ps, qs, wo_) { _Pragma("unroll") for (int it = 0; it < WI; ++it) { \
            acc[it][0] = __builtin_amdgcn_mfma_f32_32x32x16_bf16(fa0[it], fb[0], acc[it][0], 0, 0, 0); SB \
            if (it < 2) B_LD1(fbn, it < 2 ? it : 0, so_, ks_) SB \
            acc[it][1] = __builtin_amdgcn_mfma_f32_32x32x16_bf16(fa0[it], fb[1], acc[it][1], 0, 0, 0); SB A_LD(it, so_, ks_) SB } }
#define G_HALF(pl, ql, ps, qs, kt_) { const int k4_ = min((kt_) + 4, nk - 1); \
        SB R_BURST1(fb0, fb1, cur, 1, pl, ql, k4_, ps, qs, wr) R_BURST2(fb1, fb0, nxt, 0, ps, qs, wr) \
        __syncthreads(); { const int t_ = cur; cur = nxt; nxt = wr; wr = t_; } }
    if (MODE == 1) {
#pragma unroll
        for (int r = 0; r < NP; ++r) { p0[r] = *(const u32x4*)(pp + (size_t)(r * 128) * ldp); p1[r] = p0[r]; p2[r] = p0[r]; }
#pragma unroll
        for (int r = 0; r < NQ; ++r) { q0[r] = *(const u32x4*)(qp + (size_t)(r * 128) * ldq); q1[r] = q0[r]; q2[r] = q0[r]; }
    }
    G_LOAD(p0, q0, 0)
    G_LOAD(p1, q1, 1)
    G_LOAD(p2, q2, 2)
    G_STORE(p0, q0, 0)
    G_LOAD(p0, q0, 3)
    G_STORE(p1, q1, STAGE)
    __syncthreads();
    F_LOAD(fa0, fb0, 0, 0)
    int cur = 0, nxt = STAGE, wr = 2 * STAGE;
    int kt = 0;
#pragma unroll 1
    for (; kt + 3 <= nk; kt += 3) {
        G_HALF(p1, q1, p2, q2, kt)
        G_HALF(p2, q2, p0, q0, kt + 1)
        G_HALF(p0, q0, p1, q1, kt + 2)
    }
    if (kt < nk) G_HALF(p1, q1, p2, q2, kt)
    if (kt + 1 < nk) G_HALF(p2, q2, p0, q0, kt + 1)
#undef G_HALF
#undef A_LD
#undef B_LD
#undef B_LD1
#undef R_BURST1
#undef R_BURST2
#undef X_LOAD
#undef X_STORE
#undef G_LOAD
#undef G_STORE
#undef F_LOAD
#undef G_MFMA
#undef SB
}
struct GSets { u32x4 p0[2], q0[2], p1[2], q1[2], p2[2], q2[2]; };
DI void gemm_issue(const bf16_t* __restrict__ P, const bf16_t* __restrict__ Q, GSets& g, int tid) {
    const bf16_t* pp = P + (size_t)(tid >> 2) * 1024 + (tid & 3) * 8;
    const bf16_t* qp = Q + (size_t)(tid >> 2) * 1024 + (tid & 3) * 8;
#pragma unroll
    for (int r = 0; r < 2; ++r) { g.p0[r] = *(const u32x4*)(pp + (size_t)(r * 128) * 1024); g.q0[r] = *(const u32x4*)(qp + (size_t)(r * 128) * 1024); }
#pragma unroll
    for (int r = 0; r < 2; ++r) { g.p1[r] = *(const u32x4*)(pp + (size_t)(r * 128) * 1024 + BK); g.q1[r] = *(const u32x4*)(qp + (size_t)(r * 128) * 1024 + BK); }
#pragma unroll
    for (int r = 0; r < 2; ++r) { g.p2[r] = *(const u32x4*)(pp + (size_t)(r * 128) * 1024 + 2 * BK); g.q2[r] = *(const u32x4*)(qp + (size_t)(r * 128) * 1024 + 2 * BK); }
}
template <int WI, int WGJ, int MODE = 0, bool ZERO = true>
DI void gemm_tile3p(const bf16_t* __restrict__ P, int ldp, const bf16_t* __restrict__ Q, int ldq,
                  unsigned char* lds, f32x16 (&acc)[WI][2], int tid, GSets& g) {
    typedef GC<WI, WGJ> C;
    constexpr int NP = C::NP, NQ = C::NQ, STAGE = C::STAGE, BI = C::BI;
    const int lane = tid & 63, wid = tid >> 6, wi = wid / WGJ, wj = wid % WGJ;
    const int lrow = tid >> 2, lch = tid & 3;
    const bf16_t* pp = P + (size_t)lrow * ldp + lch * 8;
    const bf16_t* qp = Q + (size_t)lrow * ldq + lch * 8;
    unsigned char* wP = lds + lrow * LROW + lch * 16;
    const unsigned char* rP = lds + (wi * WI * 32 + (lane & 31)) * LROW + (lane >> 5) * 16;
    const unsigned char* rQ = lds + BI * LROW + (wj * 64 + (lane & 31)) * LROW + (lane >> 5) * 16;
    static_assert(WI == 4 && WGJ == 4, "prefetching core: 256 x 256 tiles only");
    u32x4 (&p0)[2] = g.p0, (&q0)[2] = g.q0, (&p1)[2] = g.p1, (&q1)[2] = g.q1, (&p2)[2] = g.p2, (&q2)[2] = g.q2;
    bf16x8 fa0[WI], fb0[2], fb1[2];
    if (ZERO) {
#pragma unroll
        for (int it = 0; it < WI; ++it)
#pragma unroll
            for (int jt = 0; jt < 2; ++jt)
#pragma unroll
                for (int r = 0; r < 16; ++r) acc[it][jt][r] = 0.f;
    }
    constexpr int nk = 1024 / BK;
#define G_LOAD(pr, qr, kt_) if (MODE != 1) { _Pragma("unroll") for (int r = 0; r < NP; ++r) pr[r] = *(const u32x4*)(pp + (size_t)(r * 128) * ldp + (kt_) * BK); \
                              _Pragma("unroll") for (int r = 0; r < NQ; ++r) qr[r] = *(const u32x4*)(qp + (size_t)(r * 128) * ldq + (kt_) * BK); }
#define G_STORE(pr, qr, so_) { unsigned char* w_ = wP + (so_); \
                              _Pragma("unroll") for (int r = 0; r < NP; ++r) *(u32x4*)(w_ + r * 128 * LROW) = pr[r]; \
                              _Pragma("unroll") for (int r = 0; r < NQ; ++r) *(u32x4*)(w_ + BI * LROW + r * 128 * LROW) = qr[r]; }
#define F_LOAD(fa, fb, so_, ks_) { _Pragma("unroll") for (int it = 0; it < WI; ++it) fa[it] = *(const bf16x8*)(rP + (so_) + it * 32 * LROW + (ks_) * 32); \
                                  _Pragma("unroll") for (int jt = 0; jt < 2; ++jt) fb[jt] = *(const bf16x8*)(rQ + (so_) + jt * 32 * LROW + (ks_) * 32); }
#define G_MFMA(fa, fb) if (MODE != 2) { _Pragma("unroll") for (int it = 0; it < WI; ++it) _Pragma("unroll") for (int jt = 0; jt < 2; ++jt) \
                            acc[it][jt] = __builtin_amdgcn_mfma_f32_32x32x16_bf16(fa[it], fb[jt], acc[it][jt], 0, 0, 0); }
#define SB __builtin_amdgcn_sched_barrier(0);
#define A_LD(it_, so_, ks_) fa0[it_] = *(const bf16x8*)(rP + (so_) + (it_) * 32 * LROW + (ks_) * 32);
#define B_LD(fb, so_, ks_) { _Pragma("unroll") for (int jt = 0; jt < 2; ++jt) fb[jt] = *(const bf16x8*)(rQ + (so_) + jt * 32 * LROW + (ks_) * 32); }
#define X_LOAD(it_, pl, ql, kt_) if (MODE != 1) { if ((it_) < NP) pl[(it_) < NP ? (it_) : 0] = *(const u32x4*)(pp + (size_t)(((it_) < NP ? (it_) : 0) * 128) * ldp + (kt_) * BK); \
                                  else ql[(it_) >= NP ? (it_) - NP : 0] = *(const u32x4*)(qp + (size_t)(((it_) >= NP ? (it_) - NP : 0) * 128) * ldq + (kt_) * BK); }
#define X_STORE(it_, ps, qs, so_) { if ((it_) < NP) *(u32x4*)(wP + (so_) + ((it_) < NP ? (it_) : 0) * 128 * LROW) = ps[(it_) < NP ? (it_) : 0]; \
                                   else *(u32x4*)(wP + (so_) + BI * LROW + ((it_) >= NP ? (it_) - NP : 0) * 128 * LROW) = qs[(it_) >= NP ? (it_) - NP : 0]; }
#define B_LD1(fbn, jt_, so_, ks_) fbn[jt_] = *(const bf16x8*)(rQ + (so_) + (jt_) * 32 * LROW + (ks_) * 32);
#define R_BURST1(fb, fbn, so_, ks_, pl, ql, kt_, ps, qs, wo_) { _Pragma("unroll") for (int it = 0; it < WI; ++it) { \
            acc[it][0] = __builtin_amdgcn_mfma_f32_32x32x16_bf16(fa0[it], fb[0], acc[it][0], 0, 0, 0); SB \
            if (it < 2) B_LD1(fbn, it < 2 ? it : 0, so_, ks_) X_STORE(it, ps, qs, wo_) SB \
            acc[it][1] = __builtin_amdgcn_mfma_f32_32x32x16_bf16(fa0[it], fb[1], acc[it][1], 0, 0, 0); SB A_LD(it, so_, ks_) X_LOAD(it, pl, ql, kt_) SB } }
#define R_BURST2(fb, fbn, so_, ks_, ps, qs, wo_) { _Pragma("unroll") for (int it = 0; it < WI; ++it) { \
            acc[it][0] = __builtin_amdgcn_mfma_f32_32x32x16_bf16(fa0[it], fb[0], acc[it][0], 0, 0, 0); SB \
            if (it < 2) B_LD1(fbn, it < 2 ? it : 0, so_, ks_) SB \
            acc[it][1] = __builtin_amdgcn_mfma_f32_32x32x16_bf16(fa0[it], fb[1], acc[it][1], 0, 0, 0); SB A_LD(it, so_, ks_) SB } }
#define G_HALF(pl, ql, ps, qs, kt_) { const int k4_ = min((kt_) + 4, nk - 1); \
        SB R_BURST1(fb0, fb1, cur, 1, pl, ql, k4_, ps, qs, wr) R_BURST2(fb1, fb0, nxt, 0, ps, qs, wr) \
        __syncthreads(); { const int t_ = cur; cur = nxt; nxt = wr; wr = t_; } }
#define R_BURST1N(fb, fbn, so_, ks_) { _Pragma("unroll") for (int it = 0; it < WI; ++it) { \
            acc[it][0] = __builtin_amdgcn_mfma_f32_32x32x16_bf16(fa0[it], fb[0], acc[it][0], 0, 0, 0); SB \
            if (it < 2) B_LD1(fbn, it < 2 ? it : 0, so_, ks_) SB \
            acc[it][1] = __builtin_amdgcn_mfma_f32_32x32x16_bf16(fa0[it], fb[1], acc[it][1], 0, 0, 0); SB A_LD(it, so_, ks_) SB } }
#define R_BURST1S(fb, fbn, so_, ks_, ps, qs, wo_) { _Pragma("unroll") for (int it = 0; it < WI; ++it) { \
            acc[it][0] = __builtin_amdgcn_mfma_f32_32x32x16_bf16(fa0[it], fb[0], acc[it][0], 0, 0, 0); SB \
            if (it < 2) B_LD1(fbn, it < 2 ? it : 0, so_, ks_) X_STORE(it, ps, qs, wo_) SB \
            acc[it][1] = __builtin_amdgcn_mfma_f32_32x32x16_bf16(fa0[it], fb[1], acc[it][1], 0, 0, 0); SB A_LD(it, so_, ks_) SB } }
#define G_HALF_NL(ps, qs, kt_) { SB R_BURST1S(fb0, fb1, cur, 1, ps, qs, wr) R_BURST2(fb1, fb0, nxt, 0, ps, qs, wr) \
        __syncthreads(); { const int t_ = cur; cur = nxt; nxt = wr; wr = t_; } }
#define G_HALF_NN(kt_) { SB R_BURST1N(fb0, fb1, cur, 1) R_BURST1N(fb1, fb0, nxt, 0) \
        __syncthreads(); { const int t_ = cur; cur = nxt; nxt = wr; wr = t_; } }
    G_STORE(p0, q0, 0)
    G_LOAD(p0, q0, 3)
    G_STORE(p1, q1, STAGE)
    __syncthreads();
    F_LOAD(fa0, fb0, 0, 0)
    int cur = 0, nxt = STAGE, wr = 2 * STAGE;
    int kt = 0;
#pragma unroll 1
    for (; kt + 3 <= nk - 4; kt += 3) {
        G_HALF(p1, q1, p2, q2, kt)
        G_HALF(p2, q2, p0, q0, kt + 1)
        G_HALF(p0, q0, p1, q1, kt + 2)
    }
    G_HALF(p1, q1, p2, q2, nk - 5)
    G_HALF_NL(p0, q0, nk - 4)
    G_HALF_NL(p1, q1, nk - 3)
    G_HALF_NN(nk - 2)
    G_HALF_NN(nk - 1)
#undef G_HALF
#undef G_HALF_NL
#undef G_HALF_NN
#undef R_BURST1N
#undef R_BURST1S
#undef A_LD
#undef B_LD
#undef B_LD1
#undef R_BURST1
#undef R_BURST2
#undef X_LOAD
#undef X_STORE
#undef G_LOAD
#undef G_STORE
#undef F_LOAD
#undef G_MFMA
#undef SB
}

template <int WI, int WGJ, class GetF, class FinF>
DI void staged_rows(unsigned char* lds, int tid, GetF get, FinF fin) {
    constexpr int WGI = 8 / WGJ, BI = WGI * WI * 32, RS = BI * 2 + 16, ROWS = WGJ * 32, NCH = BI / 8;
    const int lane = tid & 63, wid = tid >> 6, wi = wid / WGJ, wj = wid % WGJ, h = lane >> 5, ln = lane & 31;
#pragma unroll
    for (int jt = 0; jt < 2; ++jt) {
        unsigned char* wrow = lds + (wj * 32 + ln) * RS + (wi * WI * 32 + 4 * h) * 2;
#pragma unroll
        for (int it = 0; it < WI; ++it)
#pragma unroll
            for (int g = 0; g < 4; ++g) *(u32x2*)(wrow + (it * 32 + 8 * g) * 2) = get(it, jt, g);
        __syncthreads();
#pragma unroll 1
        for (int c = 0; c < ROWS * NCH / NT; ++c) {
            const int idx = tid + c * NT, lr = idx / NCH, ch = idx % NCH;
            const u32x4 v = *(const u32x4*)(lds + lr * RS + ch * 16);
            fin((lr >> 5) * 64 + jt * 32 + (lr & 31), ch * 8, v);
        }
        __syncthreads();
    }
}

struct X8 { f32x4 a, b; };
template <int WI, int WGJ, class GetF, class LdF, class FinF>
DI void staged_rows_rmw(unsigned char* lds, int tid, GetF get, LdF ld, FinF fin) {
    constexpr int WGI = 8 / WGJ, BI = WGI * WI * 32, RS = BI * 2 + 16, ROWS = WGJ * 32, NCH = BI / 8, NIT = ROWS * NCH / NT;
    const int lane = tid & 63, wid = tid >> 6, wi = wid / WGJ, wj = wid % WGJ, h = lane >> 5, ln = lane & 31;
#pragma unroll
    for (int jt = 0; jt < 2; ++jt) {
        unsigned char* wrow = lds + (wj * 32 + ln) * RS + (wi * WI * 32 + 4 * h) * 2;
#pragma unroll
        for (int it = 0; it < WI; ++it)
#pragma unroll
            for (int g = 0; g < 4; ++g) *(u32x2*)(wrow + (it * 32 + 8 * g) * 2) = get(it, jt, g);
        constexpr int NGRP = 2, GSZ = NIT / NGRP;
        __syncthreads();
#pragma unroll 1
        for (int gq = 0; gq < NGRP; ++gq) {
            decltype(ld(0, 0)) fetched[GSZ];
#pragma unroll
            for (int c = 0; c < GSZ; ++c) {
                const int idx = tid + (gq * GSZ + c) * NT, lr = idx / NCH, ch = idx % NCH;
                fetched[c] = ld((lr >> 5) * 64 + jt * 32 + (lr & 31), ch * 8);
            }
#pragma unroll
            for (int c = 0; c < GSZ; ++c) {
                const int idx = tid + (gq * GSZ + c) * NT, lr = idx / NCH, ch = idx % NCH;
                const u32x4 v = *(const u32x4*)(lds + lr * RS + ch * 16);
                fin((lr >> 5) * 64 + jt * 32 + (lr & 31), ch * 8, v, fetched[c]);
            }
        }
        __syncthreads();
    }
}

template <int NROWS, int NCOLS>
DI void tile_rstd(const bf16_t* base, int ld, float* out, int tid) {
    constexpr int TPR = NT / NROWS, PER = NCOLS / TPR;
    const int row = tid / TPR, part = tid % TPR;
    const bf16_t* p = base + (size_t)row * ld + part * PER;
    float s = 0.f;
#pragma unroll
    for (int c = 0; c < PER / 8; ++c) {
        u32x4 v = *(const u32x4*)(p + c * 8);
#pragma unroll
        for (int e = 0; e < 4; ++e) { float a = bf_lo(v[e]), b = bf_hi(v[e]); s += a * a + b * b; }
    }
    s += __shfl_xor(s, 1);
    if (TPR == 4) s += __shfl_xor(s, 2);
    if (part == 0) out[row] = 1.0f / sqrtf(s * (1.0f / NCOLS) + EPS);
}

DI void sincos_acc(float angf, float& c, float& s) {
    const double a = (double)angf;
    const double kd = rint(a * 0.6366197723675814);
    double r = fma(-kd, 1.5707963267948966, a);
    r = fma(-kd, 6.123233995736766e-17, r);
    const int k = (int)kd;
    const double r2 = r * r;
    const double sp = r * (1.0 + r2 * (-1.0 / 6 + r2 * (1.0 / 120 + r2 * (-1.0 / 5040 + r2 * (1.0 / 362880 + r2 * (-1.0 / 39916800))))));
    const double cp = 1.0 + r2 * (-0.5 + r2 * (1.0 / 24 + r2 * (-1.0 / 720 + r2 * (1.0 / 40320 + r2 * (-1.0 / 3628800 + r2 * (1.0 / 479001600))))));
    const int q = k & 3;
    const double ss = (q == 0) ? sp : (q == 1) ? cp : (q == 2) ? -sp : -cp;
    const double cc = (q == 0) ? cp : (q == 1) ? -sp : (q == 2) ? -cp : sp;
    c = (float)cc; s = (float)ss;
}

DI void transpose_tile(bf16_t* dst, int dst_ld, int n0, int nvalid, int nwrite, const float* src, int src_ld, int col0, int k0,
                       const float* gain, float* ldsf, int tid) {
    if (nvalid > 0) {
#pragma unroll
        for (int r = 0; r < 2; ++r) {
            const int c = tid + NT * r, kk = c >> 4, n4 = (c & 15) * 4;
            f32x4 v = __builtin_nontemporal_load((const f32x4*)(src + (size_t)(k0 + kk) * src_ld + col0 + n4));
            const float g = gain ? gain[k0 + kk] : 1.0f;
            float* d = ldsf + kk * 65 + n4;
            d[0] = v[0] * g; d[1] = v[1] * g; d[2] = v[2] * g; d[3] = v[3] * g;
        }
    }
    __syncthreads();
    const int n = tid >> 3, kc = tid & 7;
    if (n < nwrite) {
        u32x4 w = {0u, 0u, 0u, 0u};
        if (n < nvalid) {
            const float* s = ldsf + (kc * 8) * 65 + n;
            w[0] = pk2(s[0], s[65]); w[1] = pk2(s[130], s[195]); w[2] = pk2(s[260], s[325]); w[3] = pk2(s[390], s[455]);
        }
        *(u32x4*)(dst + (size_t)(n0 + n) * dst_ld + k0 + kc * 8) = w;
    }
    __syncthreads();
}

constexpr int WJ0 = 64, WJ1 = WJ0 + 768, WJ2 = WJ1 + 32, WJ3 = WJ2 + 16, WJ4 = WJ3 + 16, WJ5 = WJ4 + 16, WJ6 = WJ5 + 256, WJ7 = WJ6 + 256,
              WJ8 = WJ7 + 512, WJ9 = WJ8 + 96, WJ10 = WJ9 + 64, WJ11 = WJ10 + 256, WJ12 = WJ11 + 256, WJ13 = WJ12 + 256;
constexpr int W_EARLY = WJ5, W_ALL = WJ13;
DI void weight_tile(const Params& p, int id, float* ldsf, int tid) {
    unsigned char* ws = p.ws;
    bf16_t* wt1 = (bf16_t*)(ws + OFF_WT1);
    bf16_t* wz = (bf16_t*)(ws + OFF_WZ);
    bf16_t* wg = (bf16_t*)(ws + OFF_WG);
    if (id < WJ5) {
        int nt, kt, n0, nvalid = 64, nwrite = 64, col0;
        if (id < WJ0) { nt = id >> 4; kt = id & 15; n0 = nt * 64; col0 = nt * 64; }
        else if (id < WJ1) { const int j = id - WJ0; nt = j >> 4; kt = j & 15; n0 = 256 + nt * 64; col0 = 1440 + nt * 64; }
        else if (id < WJ2) { const int j = id - WJ1; nt = j >> 4; kt = j & 15; n0 = 3328 + nt * 64; col0 = 256 + nt * 64; }
        else if (id < WJ3) { kt = id - WJ2; n0 = 3456; col0 = 384; nvalid = 32; nwrite = 32; }
        else if (id < WJ4) { kt = id - WJ3; n0 = 3488; col0 = 4512; nvalid = 16; nwrite = 64; }
        else { kt = id - WJ4; n0 = 3552; col0 = 0; nvalid = 0; nwrite = 32; }
        transpose_tile(wt1, 1024, n0, nvalid, nwrite, p.w_in, 7600, col0, kt * 64, p.pre_g, ldsf, tid);
    } else if (id < WJ6) { const int j = id - WJ5; transpose_tile(wz, 1024, (j >> 4) * 64, 64, 64, p.w_in, 7600, 416 + (j >> 4) * 64, (j & 15) * 64, p.pre_g, ldsf, tid); }
    else if (id < WJ7) { const int j = id - WJ6; transpose_tile(wz, 1024, 1024 + (j >> 4) * 64, 64, 64, p.w_in, 7600, 4528 + (j >> 4) * 64, (j & 15) * 64, p.pre_g, ldsf, tid); }
    else if (id < WJ8) { const int j = id - WJ7; transpose_tile(wg, 1024, (j >> 4) * 64, 64, 64, p.w_in, 7600, 5552 + (j >> 4) * 64, (j & 15) * 64, p.pre_g, ldsf, tid); }
    else if (id < WJ9) { const int j = id - WJ8; transpose_tile((bf16_t*)(ws + OFF_WUQ), 256, (j >> 2) * 64, 64, 64, p.w_uq, 1536, (j >> 2) * 64, (j & 3) * 64, p.qn_g, ldsf, tid); }
    else if (id < WJ10) { const int j = id - WJ9; const int nt = j >> 1; const int col0 = nt < 16 ? nt * 128 : (nt - 16) * 128 + 64;
        transpose_tile((bf16_t*)(ws + OFF_WUKV), 128, nt * 64, 64, 64, p.w_ukv, 2048, col0, (j & 1) * 64, p.kvn_g, ldsf, tid); }
    else {
        const int j = id - WJ10; const int which = j >> 8, jj = j & 255;
        const float* src = which == 0 ? p.w_bm : which == 1 ? p.w_bf : p.w_out;
        bf16_t* dst = (bf16_t*)(ws + (which == 0 ? OFF_WBM : which == 1 ? OFF_WBF : OFF_WOUT));
        transpose_tile(dst, 1024, (jj >> 4) * 64, 64, 64, src, 1024, (jj >> 4) * 64, (jj & 15) * 64, nullptr, ldsf, tid);
    }
}

DI void phase0(const Params& p, unsigned char* smem, int tid) {
    unsigned char* ws = p.ws;
    const int bid = blockIdx.x, nblk = gridDim.x;
    const int gtid = bid * NT + tid, gsz = nblk * NT;
    if (bid == 0 && tid < 256) ((unsigned*)(ws + OFF_CTRL))[tid] = 0u;
    for (int i = gtid; i < NB * S; i += gsz) ((float*)(ws + OFF_SSQ))[i] = 0.f;
    for (int i = gtid; i < TP; i += gsz) ((float*)(ws + OFF_SSQC))[i] = 0.f;
    for (int i = gtid; i < LP * 16; i += gsz) {
        const int l = i >> 4, f = i & 15;
        const int fl = f & 3, fh = f >> 2;
        const double bd = fl == 0 ? 1.0 : fl == 1 ? 0.5623413251903491 : fl == 2 ? 0.31622776601683794 : 0.1778279410038923;
        const double sd = fh == 0 ? 1.0 : fh == 1 ? 0.1 : fh == 2 ? 0.01 : 0.001;
        const float invf = (float)(bd * sd);
        const float ang = (float)l * invf;
        float c, s; sincos_acc(ang, c, s);
        float* rp = (float*)(ws + OFF_ROPE);
        rp[l * 32 + f] = c; rp[l * 32 + 16 + f] = s;
    }
    for (int i = gtid; i < 2 * NB * NH * 64 * 12; i += gsz) {
        const int c = i % 12, row = i / 12;
        *(u32x2*)(ws + OFF_FVT + (size_t)row * (LP * 2) + L * 2 + c * 8) = (u32x2){0u, 0u};
    }
    {
        const int lane = tid & 63, gw = bid * (NT / 64) + (tid >> 6), nw = nblk * (NT / 64);
        bf16_t* hb = (bf16_t*)(ws + OFF_HB);
        float* rstd = (float*)(ws + OFF_RSTD0);
        for (int t = gw; t < TP; t += nw) {
            if (t < T) {
                const int b = t / L, l = t - b * L;
                const float* src = (l < NMETA) ? (p.meta + (size_t)l * D) : (p.x + ((size_t)b * S + (l - NMETA)) * D);
                float ss = 0.f;
#pragma unroll
                for (int c = 0; c < 4; ++c) {
                    f32x4 v = __builtin_nontemporal_load((const f32x4*)(src + (c * 64 + lane) * 4));
                    ss += v[0] * v[0] + v[1] * v[1] + v[2] * v[2] + v[3] * v[3];
                    *(u32x2*)(hb + (size_t)t * D + (c * 64 + lane) * 4) = pk4(v[0], v[1], v[2], v[3]);
                }
#pragma unroll
                for (int o = 32; o > 0; o >>= 1) ss += __shfl_xor(ss, o);
                if (lane == 0) rstd[t] = 1.0f / sqrtf(ss * (1.0f / D) + EPS);
            } else {
#pragma unroll
                for (int c = 0; c < 4; ++c) *(u32x2*)(hb + (size_t)t * D + (c * 64 + lane) * 4) = (u32x2){0u, 0u};
                if (lane == 0) rstd[t] = 0.f;
            }
        }
    }
    {
        float* ldsf = (float*)(smem + LDS_MISC);
        const int nw = (gridDim.x == 256) ? W_EARLY : W_ALL;
        for (int id = bid; id < nw; id += nblk) weight_tile(p, id, ldsf, tid);
    }
}

template <int MODE>
DI void phase1(const Params& p, unsigned char* smem, int tid) {
    unsigned char* ws = p.ws;
    unsigned char* ob = (unsigned char*)p.out;
    const bf16_t* hb = (const bf16_t*)(ws + OFF_HB);
    const bf16_t* wt1 = (const bf16_t*)(ws + OFF_WT1);
    const float* rstd = (const float*)(ws + OFF_RSTD0);
    unsigned char* lds = smem + LDS_MISC;
    const int xcd = blockIdx.x & 7, cu = blockIdx.x >> 3, per_round = gridDim.x;
    for (int rb = 0; rb < 14 * 65; rb += per_round) {
        const int idp = rb + xcd * (per_round >> 3) + cu;
        if (idp >= 14 * 65) {
            if (gridDim.x == 256) {
                constexpr int NIDLE = 4 * 256 - 14 * 65;
                int ti = tid; asm volatile("" : "+v"(ti));
                for (int id = W_EARLY + (idp - 14 * 65); id < W_ALL; id += NIDLE) weight_tile(p, id, (float*)lds, ti);
            }
            continue;
        }
        int F, tt;
        if (idp < 16 * 56) { const int g = idp / 56, rem = idp - g * 56; F = rem >> 2; tt = g * 4 + (rem & 3); }
        else { F = idp - 16 * 56; tt = 64; }
        f32x16 acc[4][2];
        if (F < 9 || F == 13) {
            const int rowbase = F * 256;
            int tl = tid; asm volatile("" : "+v"(tl));
            gemm_tile3r<4, 4, MODE>(wt1 + (size_t)rowbase * 1024, 1024, hb + (size_t)tt * 256 * 1024, 1024, 1024, lds, acc, tl);
            int te = tid; asm volatile("" : "+v"(te));
            const int lane = te & 63, wid = te >> 6, wi = wid >> 2, wj = wid & 3, h = lane >> 5, ln = lane & 31;
            if (F < 9) {
                float rsj[2];
#pragma unroll
                for (int jt = 0; jt < 2; ++jt) rsj[jt] = rstd[tt * 256 + wj * 64 + jt * 32 + ln] * ((F >= 1 && F <= 4) ? FOX_QS : 1.0f);
                bf16_t* dbase = F == 0 ? (bf16_t*)(ob + OUT_CQ) : F <= 4 ? (bf16_t*)(ws + OFF_FQ) + (F - 1) * 256 : (bf16_t*)(ws + OFF_FK) + (F - 5) * 256;
                const int dld = F == 0 ? 256 : 1024;
                if (F == 0) {
#pragma unroll
                    for (int jt = 0; jt < 2; ++jt) {
                        float sq = 0.f;
#pragma unroll
                        for (int it = 0; it < 4; ++it)
#pragma unroll
                            for (int r = 0; r < 16; ++r) { const float v = acc[it][jt][r] * rsj[jt]; sq += v * v; }
                        { const auto sw = __builtin_amdgcn_permlane32_swap(__float_as_uint(sq), __float_as_uint(sq), false, false);
                          sq = __uint_as_float(sw[0]) + __uint_as_float(sw[1]); }
                        if (h == 0) atomicAdd((float*)(ws + OFF_SSQC) + tt * 256 + wj * 64 + jt * 32 + ln, sq);
                    }
                }
                staged_rows<4, 4>(lds, te,
                    [&](int it, int jt, int g) { const float sc = rsj[jt]; return pk4(acc[it][jt][4 * g] * sc, acc[it][jt][4 * g + 1] * sc, acc[it][jt][4 * g + 2] * sc, acc[it][jt][4 * g + 3] * sc); },
                    [&](int row, int col, u32x4 v) { *(u32x4*)(dbase + (size_t)(tt * 256 + row) * dld + col) = v; });
                continue;
            }
#pragma unroll
            for (int jt = 0; jt < 2; ++jt) {
                const int t = tt * 256 + wj * 64 + jt * 32 + ln;
                const float rs = rstd[t];
                if (wi == 0) {
                    float sq = 0.f;
#pragma unroll
                    for (int it = 0; it < 4; ++it)
#pragma unroll
                        for (int r = 0; r < 16; ++r) { const float v = acc[it][jt][r] * rs; sq += v * v; }
                    { const auto sw = __builtin_amdgcn_permlane32_swap(__float_as_uint(sq), __float_as_uint(sq), false, false);
                      sq = __uint_as_float(sw[0]) + __uint_as_float(sw[1]); }
                    if (h == 0) ((float*)(ws + OFF_RKV))[t] = 1.0f / sqrtf(sq * (1.0f / 128) + EPS);
                }
#pragma unroll
                for (int it = 0; it < 4; ++it) {
                    const int fb = rowbase + wi * 128 + it * 32;
                    if (fb < 3456) {
                        bf16_t* dst; float sc = rs;
                        if (fb < 256) dst = (bf16_t*)(ob + OUT_CQ) + (size_t)t * 256 + fb;
                        else if (fb < 1280) { dst = (bf16_t*)(ws + OFF_FQ) + (size_t)t * 1024 + (fb - 256); sc = rs * FOX_QS; }
                        else if (fb < 2304) dst = (bf16_t*)(ws + OFF_FK) + (size_t)t * 1024 + (fb - 1280);
                        else dst = (bf16_t*)(ob + OUT_CKV) + (size_t)t * 128 + (fb - 3328);
#pragma unroll
                        for (int g = 0; g < 4; ++g)
                            *(u32x2*)(dst + 8 * g + 4 * h) = pk4(acc[it][jt][4 * g] * sc, acc[it][jt][4 * g + 1] * sc, acc[it][jt][4 * g + 2] * sc, acc[it][jt][4 * g + 3] * sc);
                    } else if (fb == 3456) {
                        float* dst = (float*)(ob + OUT_KPE) + (size_t)t * 32;
#pragma unroll
                        for (int g = 0; g < 4; ++g)
                            *(f32x4*)(dst + 8 * g + 4 * h) = (f32x4){acc[it][jt][4 * g] * rs, acc[it][jt][4 * g + 1] * rs, acc[it][jt][4 * g + 2] * rs, acc[it][jt][4 * g + 3] * rs};
                    } else if (fb == 3488) {
                        float* dst = (float*)(ws + OFF_FLOGIT) + (size_t)t * 16;
#pragma unroll
                        for (int g = 0; g < 2; ++g)
                            *(f32x4*)(dst + 8 * g + 4 * h) = (f32x4){acc[it][jt][4 * g] * rs, acc[it][jt][4 * g + 1] * rs, acc[it][jt][4 * g + 2] * rs, acc[it][jt][4 * g + 3] * rs};
                    }
                }
            }
        } else {
            const int fn = F - 9;
            int tl = tid; asm volatile("" : "+v"(tl));
            gemm_tile3r<4, 4, MODE>(hb + (size_t)tt * 256 * 1024, 1024, wt1 + (size_t)(2304 + fn * 256) * 1024, 1024, 1024, lds, acc, tl);
            int te = tid; asm volatile("" : "+v"(te));
            const int lane = te & 63, wid = te >> 6, wi = wid >> 2, h = lane >> 5; (void)lane;
            bf16_t* fvt = (bf16_t*)(ws + OFF_FVT);
            staged_rows<4, 4>(lds, te,
                [&](int it, int jt, int g) { const f32x4 rs = *(const f32x4*)(rstd + tt * 256 + wi * 128 + it * 32 + 8 * g + 4 * h);
                    return pk4(acc[it][jt][4 * g] * rs[0], acc[it][jt][4 * g + 1] * rs[1], acc[it][jt][4 * g + 2] * rs[2], acc[it][jt][4 * g + 3] * rs[3]); },
                [&](int row, int col, u32x4 v) { const int feat = fn * 256 + row, t = tt * 256 + col;
                    if (t < T) { const int b = t / L, l = t - b * L; *(u32x4*)(fvt + ((size_t)(b * NH + (feat >> 6)) * 64 + (feat & 63)) * LP + l) = v; } });
        }
    }
}

DI float log_sigmoid(float x) { return fminf(x, 0.f) - log1pf(__expf(-fabsf(x))); }

DI void phase2(const Params& p, unsigned char* smem, int tid) {
    unsigned char* ws = p.ws;
    unsigned char* ob = (unsigned char*)p.out;
    unsigned char* lds = smem + LDS_MISC;
    float* lrs = (float*)smem;
    const bf16_t* cq = (const bf16_t*)(ob + OUT_CQ);
    const bf16_t* ckv = (const bf16_t*)(ob + OUT_CKV);
    const float* rope = (const float*)(ws + OFF_ROPE);
    constexpr int U_SCAN = 64, U_Q = U_SCAN + 6 * 65, U_KN = U_Q + 4 * 65, U_V = U_KN + 4 * 65, U_KPE = U_V + 130, U_KMAX = U_KPE + 129;
    const int tid_in = tid;
    for (int id = blockIdx.x; id < U_KMAX; id += gridDim.x) {
        __syncthreads();
        int tid = tid_in; asm volatile("" : "+v"(tid));
        const int lane = tid & 63, wid = tid >> 6; (void)lane; (void)wid;
        if (id < U_SCAN) {
            const int b = id >> 4, hd = id & 15;
            const float fb = p.fox_b[hd];
            const float* fl = (const float*)(ws + OFF_FLOGIT) + (size_t)b * L * 16 + hd;
            float* wsum = (float*)smem;
            const int l0 = tid * 9;
            float v[9];
#pragma unroll
            for (int i = 0; i < 9; ++i) { const int l = l0 + i; v[i] = (l < L) ? fl[(size_t)l * 16] : 0.f; }
            float run = 0.f;
#pragma unroll
            for (int i = 0; i < 9; ++i) { const int l = l0 + i; run += (l < L) ? log_sigmoid(v[i] + fb) : 0.f; v[i] = run; }
            float inc = run;
#pragma unroll
            for (int o = 1; o < 64; o <<= 1) { const float u = __shfl_up(inc, o); if (lane >= o) inc += u; }
            if (lane == 63) wsum[wid] = inc;
            __syncthreads();
            float base = inc - run;
            for (int w = 0; w < wid; ++w) base += wsum[w];
            float* bias = (float*)(ws + OFF_BIAS) + (size_t)(b * NH + hd) * LP;
#pragma unroll
            for (int i = 0; i < 9; ++i) { const int l = l0 + i; if (l < LP) bias[l] = (l < L) ? -(base + v[i]) * LOG2E : 0.f; }
            __syncthreads();
        } else if (id < U_Q) {
            const int j = id - U_SCAN, f = j / 65, tt = j - f * 65;
            f32x16 acc[4][2];
            { int tl = tid; asm volatile("" : "+v"(tl));
              gemm_tile2<4, 4>((const bf16_t*)(ws + OFF_WUQ) + (size_t)f * 256 * 256, 256, cq + (size_t)tt * 256 * 256, 256, 256, lds, acc, tl); }
            int te = tid; asm volatile("" : "+v"(te));
            const int lane = te & 63, wid = te >> 6, wi = wid >> 2, wj = wid & 3, h = lane >> 5, ln = lane & 31; (void)wi; (void)wj; (void)h; (void)ln;
#pragma unroll
            for (int jt = 0; jt < 2; ++jt) {
                const int tl = wj * 64 + jt * 32 + ln, t = tt * 256 + tl;
                const float rq = MLA_QS / sqrtf(((const float*)(ws + OFF_SSQC))[t] * (1.0f / 256) + EPS);
                const int pos = t % L;
#pragma unroll
                for (int it = 0; it < 4; ++it) {
                    const int blk = (f * 256 + wi * 128 + it * 32) >> 5, hd = blk / 3, part = blk - hd * 3;
                    if (part < 2) {
#pragma unroll
                        for (int r = 0; r < 16; ++r) acc[it][jt][r] *= rq;
                    } else {
                        const float* rp = rope + (size_t)pos * 32;
#pragma unroll
                        for (int g = 0; g < 2; ++g) {
                            const f32x4 c4 = *(const f32x4*)(rp + 8 * g + 4 * h), s4 = *(const f32x4*)(rp + 16 + 8 * g + 4 * h);
#pragma unroll
                            for (int e = 0; e < 4; ++e) {
                                const float x1 = acc[it][jt][4 * g + e] * rq, x2 = acc[it][jt][4 * g + e + 8] * rq;
                                acc[it][jt][4 * g + e] = x1 * c4[e] - x2 * s4[e]; acc[it][jt][4 * g + e + 8] = x1 * s4[e] + x2 * c4[e];
                            }
                        }
                    }
                }
            }
            {
                bf16_t* qn = (bf16_t*)(ws + OFF_QN); bf16_t* qpe = (bf16_t*)(ws + OFF_QPE);
                staged_rows<4, 4>(lds, te,
                    [&](int it, int jt, int g) { return pk4(acc[it][jt][4 * g], acc[it][jt][4 * g + 1], acc[it][jt][4 * g + 2], acc[it][jt][4 * g + 3]); },
                    [&](int row, int col, u32x4 v) { const int t = tt * 256 + row, ff = f * 256 + col, blk = ff >> 5, hd = blk / 3, part = blk - hd * 3;
                        bf16_t* d = part < 2 ? qn + (size_t)t * 1024 + hd * 64 + part * 32 + (ff & 31) : qpe + (size_t)t * 512 + hd * 32 + (ff & 31);
                        *(u32x4*)d = v; });
            }
        } else if (id < U_KN) {
            const int j = id - U_Q, f = j / 65, tt = j - f * 65;
            f32x16 acc[4][2];
            { int tl = tid; asm volatile("" : "+v"(tl));
              gemm_tile2<4, 4>((const bf16_t*)(ws + OFF_WUKV) + (size_t)f * 256 * 128, 128, ckv + (size_t)tt * 256 * 128, 128, 128, lds, acc, tl); }
            int te = tid; asm volatile("" : "+v"(te));
            const int lane = te & 63, wid = te >> 6, wi = wid >> 2, wj = wid & 3, h = lane >> 5, ln = lane & 31; (void)wi; (void)wj; (void)h; (void)ln;
            {
                float rk[2];
#pragma unroll
                for (int jt = 0; jt < 2; ++jt) rk[jt] = ((const float*)(ws + OFF_RKV))[tt * 256 + wj * 64 + jt * 32 + ln];
                bf16_t* km = (bf16_t*)(ob + OUT_KM);
                staged_rows<4, 4>(lds, te,
                    [&](int it, int jt, int g) { const float sc = rk[jt]; return pk4(acc[it][jt][4 * g] * sc, acc[it][jt][4 * g + 1] * sc, acc[it][jt][4 * g + 2] * sc, acc[it][jt][4 * g + 3] * sc); },
                    [&](int row, int col, u32x4 v) { const int t = tt * 256 + row, ff = f * 256 + col;
                        *(u32x4*)(km + (size_t)t * 1536 + (ff >> 6) * 96 + (ff & 63)) = v; });
            }
        } else if (id < U_V) {
            const int j = id - U_KN, fn = j / 65, tt = j - fn * 65;
            f32x16 acc[4][2];
            { int tl = tid; asm volatile("" : "+v"(tl));
              gemm_tile2<4, 4>(ckv + (size_t)tt * 256 * 128, 128, (const bf16_t*)(ws + OFF_WUKV) + (size_t)(1024 + fn * 256) * 128, 128, 128, lds, acc, tl); }
            int te = tid; asm volatile("" : "+v"(te));
            const int lane = te & 63, wid = te >> 6, wi = wid >> 2, wj = wid & 3, h = lane >> 5, ln = lane & 31; (void)wi; (void)wj; (void)h; (void)ln;
            bf16_t* vmt = (bf16_t*)(ws + OFF_VMT);
            staged_rows<4, 4>(lds, te,
                [&](int it, int jt, int g) { const f32x4 rs = *(const f32x4*)((const float*)(ws + OFF_RKV) + tt * 256 + wi * 128 + it * 32 + 8 * g + 4 * h);
                    return pk4(acc[it][jt][4 * g] * rs[0], acc[it][jt][4 * g + 1] * rs[1], acc[it][jt][4 * g + 2] * rs[2], acc[it][jt][4 * g + 3] * rs[3]); },
                [&](int row, int col, u32x4 v) { const int feat = fn * 256 + row, t = tt * 256 + col;
                    if (t < T) { const int b = t / L, l = t - b * L; *(u32x4*)(vmt + ((size_t)(b * NH + (feat >> 6)) * 64 + (feat & 63)) * LP + l) = v; } });
        } else if (id >= U_KPE) {
            const int row = (id - U_KPE) * 128 + (tid >> 2), q = tid & 3;
            float v[4] = {0.f, 0.f, 0.f, 0.f};
            if (row < T) {
                const bf16_t* kp = (const bf16_t*)(ws + OFF_FK) + (size_t)row * 1024 + q * 256;
#pragma unroll
                for (int hh = 0; hh < 4; ++hh)
#pragma unroll
                    for (int c = 0; c < 8; ++c) {
                        const u32x4 w = *(const u32x4*)(kp + hh * 64 + c * 8);
#pragma unroll
                        for (int e = 0; e < 4; ++e) { const float a = bf_lo(w[e]), b2 = bf_hi(w[e]); v[hh] += a * a + b2 * b2; }
                    }
            }
#pragma unroll
            for (int hh = 0; hh < 4; ++hh) {
#pragma unroll
                for (int o = 4; o < 64; o <<= 1) v[hh] = fmaxf(v[hh], __shfl_xor(v[hh], o));
            }
            const int row0 = (id - U_KPE) * 128 + wid * 16;
            if (lane < 4 && row0 < T) {
                unsigned* km2 = (unsigned*)(ws + OFF_CTRL) + 64 + (row0 / L) * NH + lane * 4;
#pragma unroll
                for (int hh = 0; hh < 4; ++hh) atomicMax(km2 + hh, __float_as_uint(v[hh]));
            }
        } else {
            const int item = (id - U_V) * NT + tid;
            const int t = item >> 2, q = item & 3;
            const int pos = t % L;
            const float* kp = (const float*)(ob + OUT_KPE) + (size_t)t * 32 + q * 4;
            const f32x4 x1 = *(const f32x4*)kp, x2 = *(const f32x4*)(kp + 16);
            const f32x4 c4 = *(const f32x4*)(rope + (size_t)pos * 32 + q * 4), s4 = *(const f32x4*)(rope + (size_t)pos * 32 + 16 + q * 4);
            const u32x2 y1 = pk4(x1[0] * c4[0] - x2[0] * s4[0], x1[1] * c4[1] - x2[1] * s4[1], x1[2] * c4[2] - x2[2] * s4[2], x1[3] * c4[3] - x2[3] * s4[3]);
            const u32x2 y2 = pk4(x1[0] * s4[0] + x2[0] * c4[0], x1[1] * s4[1] + x2[1] * c4[1], x1[2] * s4[2] + x2[2] * c4[2], x1[3] * s4[3] + x2[3] * c4[3]);
            bf16_t* dst = (bf16_t*)(ob + OUT_KM) + (size_t)t * 1536 + 64 + q * 4;
#pragma unroll
            for (int hd = 0; hd < NH; ++hd) { *(u32x2*)(dst + hd * 96) = y1; *(u32x2*)(dst + hd * 96 + 16) = y2; }
        }
    }
}

template <int DK, bool FOX>
DI void attn_unit(const bf16_t* qa, int ldqa, const bf16_t* qb, int ldqb,
                  const bf16_t* kbase, int ldk,
                  const bf16_t* vt,
                  const float* bias,
                  bf16_t* obase, int ldo,
                  int qi, unsigned char* lds, int tid, float kmax2 = 0.f, int* flags = nullptr) {
    constexpr int KS = DK / 16, KROW = DK * 2 + 16, VROW = 136;
    constexpr int KBYTES = 64 * KROW, VBYTES = 64 * VROW, STG = KBYTES + VBYTES + 256;
    constexpr int KCH = DK / 8;
    constexpr int NKC = 64 * KCH / NT;
    const int lane = tid & 63, wid = tid >> 6, h = lane >> 5, ln = lane & 31;
    const int q0 = NMETA + 256 * qi;
    const int qw0 = q0 + 32 * wid;
    const int myq = qw0 + ln;
    const int nkt = (q0 + 255) / 64 + 1;
    bf16x8 qf[KS];
#pragma unroll
    for (int ks = 0; ks < KS; ++ks) {
        if (ks < 4) qf[ks] = *(const bf16x8*)(qa + (size_t)myq * ldqa + ks * 16 + h * 8);
        else qf[ks] = *(const bf16x8*)(qb + (size_t)myq * ldqb + (ks - 4) * 16 + h * 8);
    }
    f32x16 o[2];
#pragma unroll
    for (int d = 0; d < 2; ++d)
#pragma unroll
        for (int r = 0; r < 16; ++r) o[d][r] = 0.f;
    float m = -INFINITY, lsum = 0.f;
    float qkb = 0.f; bool wdone = false;
    if (FOX) {
        float q2 = 0.f;
#pragma unroll
        for (int ks = 0; ks < 4; ++ks) {
            const u32x4 w = __builtin_bit_cast(u32x4, qf[ks]);
#pragma unroll
            for (int e = 0; e < 4; ++e) { const float a = bf_lo(w[e]), b2 = bf_hi(w[e]); q2 += a * a + b2 * b2; }
        }
        { const auto sw = __builtin_amdgcn_permlane32_swap(__float_as_uint(q2), __float_as_uint(q2), false, false);
          q2 = __uint_as_float(sw[0]) + __uint_as_float(sw[1]); }
        qkb = sqrtf(q2 * kmax2) * 1.01f + 0.01f;
    }
    constexpr int NK2 = (64 * KCH + NT - 1) / NT;
    u32x4 kr[NK2]; u32x4 vr; float br = 0.f;
    auto gload = [&](int j) {
#pragma unroll
        for (int r = 0; r < NK2; ++r) {
            const int c = tid + NT * r;
            if (c < 64 * KCH) { const int row = c / KCH, ch = c - row * KCH; kr[r] = *(const u32x4*)(kbase + (size_t)(64 * j + row) * ldk + ch * 8); }
        }
        { const int row = tid >> 3, ch = tid & 7; vr = *(const u32x4*)(vt + (size_t)row * LP + 64 * j + ch * 8); }
        if (FOX) { if (tid < 64) br = bias[64 * j + tid]; }
    };
    auto lstore = [&](int st) {
        unsigned char* base = lds + st * STG;
#pragma unroll
        for (int r = 0; r < NK2; ++r) {
            const int c = tid + NT * r;
            if (c < 64 * KCH) { const int row = c / KCH, ch = c - row * KCH; *(u32x4*)(base + row * KROW + ch * 16) = kr[r]; }
        }
        { const int row = tid >> 3, ch = tid & 7; unsigned char* d = base + KBYTES + row * VROW + ch * 16;
          *(u32x2*)d = (u32x2){vr[0], vr[1]}; *(u32x2*)(d + 8) = (u32x2){vr[2], vr[3]}; }
        if (FOX) { if (tid < 64) *(float*)(base + KBYTES + VBYTES + tid * 4) = br; }
    };
    const int jlast = nkt - 1;
    gload(jlast); lstore(0);
    __syncthreads();
    m = -1e30f;
#pragma unroll 1
    for (int itn = 0; itn < nkt; ++itn) {
        const int j = jlast - itn;
        const int st = itn & 1;
        if (j > 0) gload(j - 1);
        if (FOX && !wdone && 64 * j <= qw0 + 31) {
            const float bmax = *(const float*)(lds + st * STG + KBYTES + VBYTES + 63 * 4);
            const bool need = !((m > -1e29f) && (qkb + bmax < m - 40.0f));
            if (__builtin_amdgcn_ballot_w64(need) == 0ull) wdone = true;
        }
        if (!wdone && 64 * j <= qw0 + 31) {
            const unsigned char* kb = lds + st * STG;
            const unsigned char* vb = kb + KBYTES;
            f32x16 s[2];
            if (FOX) {
                const float* bl = (const float*)(vb + VBYTES);
#pragma unroll
                for (int t2 = 0; t2 < 2; ++t2)
#pragma unroll
                    for (int g = 0; g < 4; ++g) {
                        const f32x4 b4 = *(const f32x4*)(bl + t2 * 32 + 8 * g + 4 * h);
                        s[t2][4 * g] = b4[0]; s[t2][4 * g + 1] = b4[1]; s[t2][4 * g + 2] = b4[2]; s[t2][4 * g + 3] = b4[3];
                    }
            } else {
#pragma unroll
                for (int t2 = 0; t2 < 2; ++t2)
#pragma unroll
                    for (int r = 0; r < 16; ++r) s[t2][r] = 0.f;
            }
            bf16x8 kf[KS][2];
#pragma unroll
            for (int ks = 0; ks < KS; ++ks)
#pragma unroll
                for (int t2 = 0; t2 < 2; ++t2) kf[ks][t2] = *(const bf16x8*)(kb + (t2 * 32 + ln) * KROW + ks * 32 + h * 16);
            __builtin_amdgcn_sched_barrier(0);
#pragma unroll
            for (int ks = 0; ks < KS; ++ks)
#pragma unroll
                for (int t2 = 0; t2 < 2; ++t2) s[t2] = __builtin_amdgcn_mfma_f32_32x32x16_bf16(kf[ks][t2], qf[ks], s[t2], 0, 0, 0);
            __builtin_amdgcn_sched_barrier(0);
            u32x2 vf[4][2][2];
#pragma unroll
            for (int kk = 0; kk < 4; ++kk)
#pragma unroll
                for (int d = 0; d < 2; ++d) {
                    const unsigned char* va = vb + (d * 32 + ln) * VROW + (16 * kk + 4 * h) * 2;
                    vf[kk][d][0] = *(const u32x2*)va; vf[kk][d][1] = *(const u32x2*)(va + 16);
                }
            __builtin_amdgcn_sched_barrier(0);
            if (64 * j + 63 > qw0) {
                const int thr = myq - 64 * j - 4 * h;
#pragma unroll
                for (int t2 = 0; t2 < 2; ++t2)
#pragma unroll
                    for (int r = 0; r < 16; ++r) { if (((r & 3) + 8 * (r >> 2) + 32 * t2) > thr) s[t2][r] = -INFINITY; }
            }
            float mxa[2];
#pragma unroll
            for (int t2 = 0; t2 < 2; ++t2) {
                float x0 = fmaxf(fmaxf(s[t2][0], s[t2][1]), s[t2][2]);
                float x1 = fmaxf(fmaxf(s[t2][3], s[t2][4]), s[t2][5]);
                float x2 = fmaxf(fmaxf(s[t2][6], s[t2][7]), s[t2][8]);
                float x3 = fmaxf(fmaxf(s[t2][9], s[t2][10]), s[t2][11]);
                float x4 = fmaxf(fmaxf(s[t2][12], s[t2][13]), s[t2][14]);
                mxa[t2] = fmaxf(fmaxf(fmaxf(x0, x1), x2), fmaxf(fmaxf(x3, x4), s[t2][15]));
            }
            float mx = fmaxf(mxa[0], mxa[1]);
            { const auto sw = __builtin_amdgcn_permlane32_swap(__float_as_uint(mx), __float_as_uint(mx), false, false);
              mx = fmaxf(__uint_as_float(sw[0]), __uint_as_float(sw[1])); }
            if (__builtin_amdgcn_ballot_w64(mx > m + 8.0f) != 0ull) {
                const float mn = fmaxf(m, mx);
                const float alpha = __builtin_amdgcn_exp2f(m - mn);
                m = mn;
                lsum *= alpha;
#pragma unroll
                for (int d = 0; d < 2; ++d)
#pragma unroll
                    for (int r = 0; r < 16; ++r) o[d][r] *= alpha;
            }
            float ps0 = 0.f, ps1 = 0.f, ps2 = 0.f, ps3 = 0.f;
#pragma unroll
            for (int t2 = 0; t2 < 2; ++t2)
#pragma unroll
                for (int r = 0; r < 16; r += 4) {
                    const float e0 = __builtin_amdgcn_exp2f(s[t2][r] - m), e1 = __builtin_amdgcn_exp2f(s[t2][r + 1] - m);
                    const float e2 = __builtin_amdgcn_exp2f(s[t2][r + 2] - m), e3 = __builtin_amdgcn_exp2f(s[t2][r + 3] - m);
                    s[t2][r] = e0; s[t2][r + 1] = e1; s[t2][r + 2] = e2; s[t2][r + 3] = e3;
                    ps0 += e0; ps1 += e1; ps2 += e2; ps3 += e3;
                }
            lsum += (ps0 + ps1) + (ps2 + ps3);
#pragma unroll
            for (int kk = 0; kk < 4; ++kk) {
                const int t2 = kk >> 1, s8 = (kk & 1) * 8;
                u32x4 pw;
                pw[0] = pk2(s[t2][s8 + 0], s[t2][s8 + 1]); pw[1] = pk2(s[t2][s8 + 2], s[t2][s8 + 3]);
                pw[2] = pk2(s[t2][s8 + 4], s[t2][s8 + 5]); pw[3] = pk2(s[t2][s8 + 6], s[t2][s8 + 7]);
                const bf16x8 pf = __builtin_bit_cast(bf16x8, pw);
#pragma unroll
                for (int d = 0; d < 2; ++d) {
                    const u32x4 vw = {vf[kk][d][0][0], vf[kk][d][0][1], vf[kk][d][1][0], vf[kk][d][1][1]};
                    o[d] = __builtin_amdgcn_mfma_f32_32x32x16_bf16(__builtin_bit_cast(bf16x8, vw), pf, o[d], 0, 0, 0);
                }
            }
        }
        if (j > 0) lstore(st ^ 1);
        if (FOX) {
            if (lane == 0) flags[(itn & 1) * 8 + wid] = wdone ? 1 : 0;
            __syncthreads();
            const u32x4 f0 = *(const u32x4*)(flags + (itn & 1) * 8), f1 = *(const u32x4*)(flags + (itn & 1) * 8 + 4);
            if ((f0[0] & f0[1] & f0[2] & f0[3] & f1[0] & f1[1] & f1[2] & f1[3]) != 0u) break;
        } else {
            __syncthreads();
        }
    }
    if (FOX) __syncthreads();
    { const auto sw = __builtin_amdgcn_permlane32_swap(__float_as_uint(lsum), __float_as_uint(lsum), false, false);
      lsum = __uint_as_float(sw[0]) + __uint_as_float(sw[1]); }
    const float inv = 1.0f / lsum;
    {
        unsigned char* sb = lds + 2 * STG + wid * (32 * 144);
#pragma unroll
        for (int d = 0; d < 2; ++d)
#pragma unroll
            for (int g = 0; g < 4; ++g)
                *(u32x2*)(sb + ln * 144 + (d * 32 + 8 * g + 4 * h) * 2) = pk4(o[d][4 * g] * inv, o[d][4 * g + 1] * inv, o[d][4 * g + 2] * inv, o[d][4 * g + 3] * inv);
        __builtin_amdgcn_fence(__ATOMIC_RELEASE, "wavefront");
        __builtin_amdgcn_wave_barrier();
        __builtin_amdgcn_fence(__ATOMIC_ACQUIRE, "wavefront");
#pragma unroll
        for (int ps = 0; ps < 4; ++ps) {
            const int row = ps * 8 + (lane >> 3), ch = lane & 7;
            const u32x4 v = *(const u32x4*)(sb + row * 144 + ch * 16);
            *(u32x4*)(obase + (size_t)(qw0 + row) * ldo + ch * 8) = v;
        }
    }
}

DI void phase3(const Params& p, unsigned char* smem, int tid, int cidx) {
    unsigned char* ws = p.ws;
    unsigned char* ob = (unsigned char*)p.out;
    unsigned char* lds = smem + LDS_MISC;
    unsigned* ctr = (unsigned*)(ws + OFF_CTRL) + cidx;
    int* sh = (int*)smem;
    int* flags = (int*)(smem + 1056);
    const float* kmax2 = (const float*)(ws + OFF_CTRL) + 64;
    if (gridDim.x == 256) {
        const int xcd = blockIdx.x & 7, cu = blockIdx.x >> 3, s4 = (cu >> 3) & 3, j8 = cu & 7;
        for (int r = 0; r < 2; ++r) {
            const int bh = (r * 4 + s4) * 8 + xcd, b = bh >> 4, hd = bh & 15;
            const size_t t0 = (size_t)b * L;
            for (int half = 0; half < 2; ++half) {
                const int qi = half == 0 ? 15 - j8 : j8;
                bf16_t* qn = (bf16_t*)(ws + OFF_QN) + t0 * 1024 + hd * 64;
                attn_unit<96, false>(qn, 1024, (const bf16_t*)(ws + OFF_QPE) + t0 * 512 + hd * 32, 512,
                                     (const bf16_t*)(ob + OUT_KM) + t0 * 1536 + hd * 96, 1536,
                                     (const bf16_t*)(ws + OFF_VMT) + (size_t)(b * NH + hd) * 64 * LP, nullptr, qn, 1024, qi, lds, tid);
            }
        }
    }
    const int nun = (gridDim.x == 256) ? 1024 : 2048;
    for (;;) {
        if (tid == 0) sh[0] = (int)atomicAdd(ctr, 1u);
        __syncthreads();
        const int u = sh[0];
        __syncthreads();
        if (u >= nun) break;
        int qi, type, bh;
        if (gridDim.x == 256) { qi = 15 - (u >> 6); bh = u & 63; type = 1; }
        else { qi = 15 - (u >> 7); const int rem = u & 127; type = rem & 1; bh = rem >> 1; }
        const int b = bh >> 4, hd = bh & 15;
        const size_t t0 = (size_t)b * L;
        if (type == 0) {
            bf16_t* qn = (bf16_t*)(ws + OFF_QN) + t0 * 1024 + hd * 64;
            attn_unit<96, false>(qn, 1024, (const bf16_t*)(ws + OFF_QPE) + t0 * 512 + hd * 32, 512,
                                 (const bf16_t*)(ob + OUT_KM) + t0 * 1536 + hd * 96, 1536,
                                 (const bf16_t*)(ws + OFF_VMT) + (size_t)(b * NH + hd) * 64 * LP, nullptr, qn, 1024, qi, lds, tid);
        } else {
            bf16_t* fq = (bf16_t*)(ws + OFF_FQ) + t0 * 1024 + hd * 64;
            attn_unit<64, true>(fq, 1024, fq, 1024, (const bf16_t*)(ws + OFF_FK) + t0 * 1024 + hd * 64, 1024,
                                (const bf16_t*)(ws + OFF_FVT) + (size_t)(b * NH + hd) * 64 * LP,
                                (const float*)(ws + OFF_BIAS) + (size_t)(b * NH + hd) * LP, fq, 1024, qi, lds, tid, kmax2[b * NH + hd], flags);
        }
    }
}

DI int real_tile_row(int tt) { return (tt >> 5) * L + NMETA + (tt & 31) * 128; }

DI int real_tile_row256(int tt) { return (tt >> 4) * L + NMETA + (tt & 15) * 256; }
constexpr size_t OFF_G = OFF_FVT;
static_assert((size_t)8 * 64 * 256 * 256 * 2 <= 2 * (size_t)NB * NH * 64 * LP * 2, "gate buffer too large");
DI void phase3b(const Params& p, unsigned char* smem, int tid) {
    unsigned char* ws = p.ws;
    const bf16_t* hb = (const bf16_t*)(ws + OFF_HB);
    const float* rstd = (const float*)(ws + OFF_RSTD0);
    unsigned char* lds = smem + LDS_MISC;
    const int xcd = blockIdx.x & 7, cu = blockIdx.x >> 3, per_round = gridDim.x;
    auto tile_ptrs = [&](int rb, const bf16_t*& P, const bf16_t*& Q) __attribute__((always_inline)) -> bool {
        const int idp = rb + xcd * (per_round >> 3) + cu;
        if (rb >= 16 * 64 || idp >= 16 * 64) return false;
        const int half = idp >> 9, i9 = idp & 511, f = (i9 & 31) >> 2, tt = (i9 >> 5) * 4 + (i9 & 3);
        P = (const bf16_t*)(ws + (half == 0 ? OFF_WZ : OFF_WG)) + (size_t)f * 256 * 1024;
        Q = hb + (size_t)real_tile_row256(tt) * 1024;
        return true;
    };
    GSets gs;
    const bf16_t* Pn = nullptr; const bf16_t* Qn = nullptr;
    bool vn = tile_ptrs(0, Pn, Qn);
    if (vn) { int ti = tid; asm volatile("" : "+v"(ti)); gemm_issue(Pn, Qn, gs, ti); }
    for (int rb = 0; rb < 16 * 64; rb += per_round) {
        const int idp = rb + xcd * (per_round >> 3) + cu;
        const bool v = vn;
        const bf16_t* P = Pn; const bf16_t* Q = Qn;
        if (!v) { vn = tile_ptrs(rb + per_round, Pn, Qn); if (vn) { int ti = tid; asm volatile("" : "+v"(ti)); gemm_issue(Pn, Qn, gs, ti); } continue; }
        const int half = idp >> 9, i9 = idp & 511;
        const int f = (i9 & 31) >> 2, tt = (i9 >> 5) * 4 + (i9 & 3);
        const int r0 = real_tile_row256(tt);
        f32x16 acc[4][2];
        { int tl = tid; asm volatile("" : "+v"(tl));
          gemm_tile3p<4, 4>(P, 1024, Q, 1024, lds, acc, tl, gs); }
        vn = tile_ptrs(rb + per_round, Pn, Qn);
        if (vn) { int ti = tid; asm volatile("" : "+v"(ti)); gemm_issue(Pn, Qn, gs, ti); }
        int te = tid; asm volatile("" : "+v"(te));
        const int lane = te & 63, wid = te >> 6, wj = wid & 3, ln = lane & 31;
        float rsj[2];
#pragma unroll
        for (int jt = 0; jt < 2; ++jt) rsj[jt] = rstd[r0 + wj * 64 + jt * 32 + ln];
        if (half == 0) {
            bf16_t* obuf = (bf16_t*)(ws + (f < 4 ? OFF_QN : OFF_FQ)) + (f & 3) * 256;
            staged_rows_rmw<4, 4>(lds, te,
                [&](int it, int jt, int g) { const float sc = rsj[jt];
                    return pk4(fsilu(acc[it][jt][4 * g] * sc), fsilu(acc[it][jt][4 * g + 1] * sc), fsilu(acc[it][jt][4 * g + 2] * sc), fsilu(acc[it][jt][4 * g + 3] * sc)); },
                [&](int row, int col) { return *(const u32x4*)(obuf + (size_t)(r0 + row) * 1024 + col); },
                [&](int row, int col, u32x4 v, u32x4 o) { u32x4 w;
#pragma unroll
                    for (int e = 0; e < 4; ++e) w[e] = pk2(bf_lo(o[e]) * bf_lo(v[e]), bf_hi(o[e]) * bf_hi(v[e]));
                    *(u32x4*)(obuf + (size_t)(r0 + row) * 1024 + col) = w; });
        } else {
            unsigned char* gt = ws + OFF_G + ((size_t)(f * 64 + tt) * 8 + wid) * 16384 + lane * 16;
#pragma unroll
            for (int it = 0; it < 4; ++it)
#pragma unroll
                for (int jt = 0; jt < 2; ++jt)
#pragma unroll
                    for (int gp = 0; gp < 2; ++gp) {
                        const float sc = rsj[jt];
                        u32x4 w;
#pragma unroll
                        for (int e = 0; e < 4; ++e) w[e] = pk2(fsigmoid(acc[it][jt][8 * gp + 2 * e] * sc), fsigmoid(acc[it][jt][8 * gp + 2 * e + 1] * sc));
                        *(u32x4*)(gt + ((it * 2 + jt) * 2 + gp) * 1024) = w;
                    }
        }
    }
}

DI void phase4(const Params& p, unsigned char* smem, int tid) {
    unsigned char* ws = p.ws;
    unsigned char* lds = smem + LDS_MISC;
    bf16_t* mx = (bf16_t*)(ws + OFF_FK);
    const int xcd = blockIdx.x & 7, cu = blockIdx.x >> 3, per_round = gridDim.x;
    for (int rb = 0; rb < 4 * 64; rb += per_round) {
        const int idp = rb + xcd * (per_round >> 3) + cu;
        if (idp >= 4 * 64) continue;
        const int f = (idp & 31) >> 3, tt = (idp >> 5) * 8 + (idp & 7);
        const int r0 = real_tile_row256(tt);
        f32x16 acc[4][2];
        { int tl = tid; asm volatile("" : "+v"(tl));
          gemm_tile3r<4, 4>((const bf16_t*)(ws + OFF_WBM) + (size_t)f * 256 * 1024, 1024, (const bf16_t*)(ws + OFF_QN) + (size_t)r0 * 1024, 1024, 1024, lds, acc, tl); }
        {
            int te = tid; asm volatile("" : "+v"(te));
            const unsigned char* ga = ws + OFF_G + ((size_t)(f * 64 + tt) * 8 + (te >> 6)) * 16384 + (te & 63) * 16;
            const unsigned char* gb = ga + (size_t)4 * 64 * 8 * 16384;
#pragma unroll
            for (int it = 0; it < 4; ++it)
#pragma unroll
                for (int jt = 0; jt < 2; ++jt)
#pragma unroll
                    for (int gp = 0; gp < 2; ++gp) {
                        const u32x4 a4 = *(const u32x4*)(ga + ((it * 2 + jt) * 2 + gp) * 1024), b4 = *(const u32x4*)(gb + ((it * 2 + jt) * 2 + gp) * 1024);
#pragma unroll
                        for (int e = 0; e < 4; ++e) {
                            acc[it][jt][8 * gp + 2 * e] *= bf_lo(a4[e]) * __builtin_amdgcn_rcpf(fmaxf(bf_lo(b4[e]), 8.6736174e-19f));
                            acc[it][jt][8 * gp + 2 * e + 1] *= bf_hi(a4[e]) * __builtin_amdgcn_rcpf(fmaxf(bf_hi(b4[e]), 8.6736174e-19f));
                        }
                    }
        }
        { int tl = tid; asm volatile("" : "+v"(tl));
          gemm_tile3r<4, 4, 0, false>((const bf16_t*)(ws + OFF_WBF) + (size_t)f * 256 * 1024, 1024, (const bf16_t*)(ws + OFF_FQ) + (size_t)r0 * 1024, 1024, 1024, lds, acc, tl); }
        {
            int te = tid; asm volatile("" : "+v"(te));
            const unsigned char* gb = ws + OFF_G + ((size_t)((4 + f) * 64 + tt) * 8 + (te >> 6)) * 16384 + (te & 63) * 16;
            staged_rows<4, 4>(lds, te,
                [&](int it, int jt, int g) { const u32x4 b4 = *(const u32x4*)(gb + ((it * 2 + jt) * 2 + (g >> 1)) * 1024); const int e0 = (g & 1) * 2;
                    const float g0 = fmaxf(bf_lo(b4[e0]), 8.6736174e-19f), g1 = fmaxf(bf_hi(b4[e0]), 8.6736174e-19f);
                    const float g2 = fmaxf(bf_lo(b4[e0 + 1]), 8.6736174e-19f), g3 = fmaxf(bf_hi(b4[e0 + 1]), 8.6736174e-19f);
                    return pk4(acc[it][jt][4 * g] * g0, acc[it][jt][4 * g + 1] * g1, acc[it][jt][4 * g + 2] * g2, acc[it][jt][4 * g + 3] * g3); },
                [&](int row, int col, u32x4 v) { *(u32x4*)(mx + (size_t)(r0 + row) * 1024 + f * 256 + col) = v; });
        }
    }
}

DI void phase5(const Params& p, unsigned char* smem, int tid, bool coop) {
    unsigned char* ws = p.ws;
    unsigned char* lds = smem + LDS_MISC;
    const bf16_t* mx = (const bf16_t*)(ws + OFF_FK);
    float* ssq = (float*)(ws + OFF_SSQ);
    const bool fused = coop && gridDim.x == 256;
    const int xcd = blockIdx.x & 7, cu = blockIdx.x >> 3, per_round = gridDim.x;
    for (int rb = 0; rb < 4 * 64; rb += per_round) {
        const int idp = rb + xcd * (per_round >> 3) + cu;
        if (idp >= 4 * 64) continue;
        const int f = (idp & 31) >> 3, tt = (idp >> 5) * 8 + (idp & 7);
        const int r0 = real_tile_row256(tt);
        f32x16 acc[4][2];
        int tl = tid; asm volatile("" : "+v"(tl));
        gemm_tile3r<4, 4>((const bf16_t*)(ws + OFF_WOUT) + (size_t)f * 256 * 1024, 1024, mx + (size_t)r0 * 1024, 1024, 1024, lds, acc, tl);
        int te = tid; asm volatile("" : "+v"(te));
        const int lane = te & 63, wid = te >> 6, wi = wid >> 2, wj = wid & 3, h = lane >> 5, ln = lane & 31;
#pragma unroll
        for (int jt = 0; jt < 2; ++jt) {
            const int tr = tt * 256 + wj * 64 + jt * 32 + ln;
            float sq = 0.f;
#pragma unroll
            for (int it = 0; it < 4; ++it)
#pragma unroll
                for (int r = 0; r < 16; ++r) sq += acc[it][jt][r] * acc[it][jt][r];
            { const auto sw = __builtin_amdgcn_permlane32_swap(__float_as_uint(sq), __float_as_uint(sq), false, false);
              sq = __uint_as_float(sw[0]) + __uint_as_float(sw[1]); }
            if (h == 0) atomicAdd(ssq + tr, sq);
        }
        if (fused) {
            unsigned* cnt = (unsigned*)(ws + OFF_CTRL) + 128 + tt;
            unsigned* bar = (unsigned*)(ws + OFF_BAR);
            asm volatile("s_waitcnt vmcnt(0)" ::: "memory");
            __syncthreads();
            if (te == 0) {
                __builtin_amdgcn_fence(__ATOMIC_RELEASE, "agent");
                (void)xb_add(cnt, 1u);
                XB_SPIN(xb_ld(cnt) < 4u, bar);
                __builtin_amdgcn_fence(__ATOMIC_ACQUIRE, "agent");
            }
            __syncthreads();
            float rsj[2];
#pragma unroll
            for (int jt = 0; jt < 2; ++jt)
                rsj[jt] = 1.0f / sqrtf(__hip_atomic_load(ssq + tt * 256 + wj * 64 + jt * 32 + ln, __ATOMIC_RELAXED, __HIP_MEMORY_SCOPE_AGENT) * (1.0f / D) + EPS);
            staged_rows_rmw<4, 4>(lds, te,
                [&](int it, int jt, int g) { const f32x4 gv = *(const f32x4*)(p.post_g + f * 256 + wi * 128 + it * 32 + 8 * g + 4 * h); const float rs = rsj[jt];
                    return pk4(acc[it][jt][4 * g] * rs * gv[0], acc[it][jt][4 * g + 1] * rs * gv[1], acc[it][jt][4 * g + 2] * rs * gv[2], acc[it][jt][4 * g + 3] * rs * gv[3]); },
                [&](int row, int col) { const size_t o = (size_t)(tt * 256 + row) * 1024 + f * 256 + col; X8 r; r.a = __builtin_nontemporal_load((const f32x4*)(p.x + o)); r.b = __builtin_nontemporal_load((const f32x4*)(p.x + o + 4)); return r; },
                [&](int row, int col, u32x4 v, X8 xv) { const size_t o = (size_t)(tt * 256 + row) * 1024 + f * 256 + col;
                    __builtin_nontemporal_store((f32x4){xv.a[0] + bf_lo(v[0]), xv.a[1] + bf_hi(v[0]), xv.a[2] + bf_lo(v[1]), xv.a[3] + bf_hi(v[1])}, (f32x4*)(p.out + o));
                    __builtin_nontemporal_store((f32x4){xv.b[0] + bf_lo(v[2]), xv.b[1] + bf_hi(v[2]), xv.b[2] + bf_lo(v[3]), xv.b[3] + bf_hi(v[3])}, (f32x4*)(p.out + o + 4)); });
        } else {
#pragma unroll
            for (int jt = 0; jt < 2; ++jt) {
                const int tr = tt * 256 + wj * 64 + jt * 32 + ln;
#pragma unroll
                for (int it = 0; it < 4; ++it) {
                    float* dst = p.out + (size_t)tr * 1024 + f * 256 + wi * 128 + it * 32;
#pragma unroll
                    for (int g = 0; g < 4; ++g)
                        *(f32x4*)(dst + 8 * g + 4 * h) = (f32x4){acc[it][jt][4 * g], acc[it][jt][4 * g + 1], acc[it][jt][4 * g + 2], acc[it][jt][4 * g + 3]};
                }
            }
        }
    }
}

DI void phase6(const Params& p, int tid) {
    const float* ssq = (const float*)(p.ws + OFF_SSQ);
    const int gsz = gridDim.x * NT;
    for (int i = blockIdx.x * NT + tid; i < NB * S * (D / 4); i += gsz) {
        const int tr = i >> 8, c = (i & 255) * 4;
        const float rs = 1.0f / sqrtf(ssq[tr] * (1.0f / D) + EPS);
        const f32x4 mv = *(const f32x4*)(p.out + (size_t)i * 4);
        const f32x4 xv = *(const f32x4*)(p.x + (size_t)i * 4);
        const f32x4 g = *(const f32x4*)(p.post_g + c);
        *(f32x4*)(p.out + (size_t)i * 4) = (f32x4){xv[0] + mv[0] * rs * g[0], xv[1] + mv[1] * rs * g[1], xv[2] + mv[2] * rs * g[2], xv[3] + mv[3] * rs * g[3]};
    }
}

template <bool COOP>
__global__ void __launch_bounds__(NT) mega(Params p, int lo, int hi) {
    extern __shared__ __attribute__((aligned(16))) unsigned char smem[];
    const int wave_s = __builtin_amdgcn_readfirstlane((int)threadIdx.x >> 6);
#define TID0 ([&]() __attribute__((always_inline)) { unsigned z_ = 0u; asm volatile("" : "+s"(z_)); return (wave_s << 6) | (int)__builtin_amdgcn_mbcnt_hi(~0u, __builtin_amdgcn_mbcnt_lo(~0u, z_)); }())
    volatile LAS unsigned* xst = (volatile LAS unsigned*)(smem + 1024);
    XcdBarrier xb; xb.bar = (unsigned*)(p.ws + OFF_BAR); xb.x = 0u; xb.st = xst;
    if (COOP) {
        if (hi < lo) cg::this_grid().sync();
        { const int t0_ = TID0; if (t0_ < 4) xst[t0_] = 0u; }
        __syncthreads();
        xb = xcd_barrier_post((unsigned*)(p.ws + OFF_BAR), xst);
    }
#define SEAM(n) if (COOP && (n) < hi) { xcd_barrier(xb); }
#define PHASE(n, call) if (lo <= (n) && (n) <= hi) { int tid = TID0; asm volatile("" : "+v"(tid)); call; SEAM(n) }
    PHASE(0, phase0(p, smem, tid))
#if PROBE_DUP & 1
    PHASE(0, phase0(p, smem, tid))
#endif
#if PROBE_DUP & 64
    if (COOP) { for (int i_ = 0; i_ < 10; ++i_) xcd_barrier(xb); }
#endif
#if PROBE_DUP & 2
    PHASE(1, phase1<PROBE_MODE>(p, smem, tid))
#endif
    PHASE(1, phase1<0>(p, smem, tid))
    PHASE(2, phase2(p, smem, tid))
#if PROBE_DUP & 4
    PHASE(2, phase2(p, smem, tid))
#endif
    PHASE(3, phase3(p, smem, tid, 0))
#if PROBE_DUP & 8
    PHASE(1, phase1<0>(p, smem, tid))
    PHASE(2, phase2(p, smem, tid))
    PHASE(3, phase3(p, smem, tid, 1))
#endif
    PHASE(4, phase3b(p, smem, tid))
    PHASE(5, phase4(p, smem, tid))
#if PROBE_DUP & 32
    PHASE(5, phase4(p, smem, tid))
#endif
    if (lo <= 6 && 6 <= hi) { int tid = TID0; asm volatile("" : "+v"(tid)); phase5(p, smem, tid, COOP); if (COOP && 6 < hi && gridDim.x != 256) xcd_barrier(xb); }
    if (lo <= 7 && 7 <= hi && (!COOP || gridDim.x != 256)) { int tid = TID0; asm volatile("" : "+v"(tid)); phase6(p, tid); }
#undef PHASE
#undef SEAM
}

extern "C" void kernel_launch(void* const* d_in, const int* in_sizes, int n_in, void* d_out, int out_size, void* d_ws, size_t ws_size,
                              hipStream_t stream) {
    static int grid = 0;
    if (grid == 0) {
        if (n_in != 13 || out_size != NB * S * D || ws_size < WS_END) {
            fprintf(stderr, "kernel_launch: unexpected shapes: n_in %d out %d ws %zu (need %zu)\n", n_in, out_size, ws_size, (size_t)WS_END);
            grid = -1; return;
        }
        int dev = 0, cus = 0, per_cu = 0;
        (void)hipGetDevice(&dev);
        (void)hipDeviceGetAttribute(&cus, hipDeviceAttributeMultiprocessorCount, dev);
#if MK_LAUNCHES == 1
        const void* fn = (const void*)mega<true>;
#else
        const void* fn = (const void*)mega<false>;
#endif
        if (hipFuncSetAttribute(fn, hipFuncAttributeMaxDynamicSharedMemorySize, LDS_BYTES) != hipSuccess) { fprintf(stderr, "kernel_launch: hipFuncSetAttribute failed\n"); grid = -1; return; }
        if (hipOccupancyMaxActiveBlocksPerMultiprocessor(&per_cu, fn, NT, LDS_BYTES) != hipSuccess || per_cu < 1) { fprintf(stderr, "kernel_launch: occupancy query failed (%d)\n", per_cu); grid = -1; return; }
        grid = cus * 1;
    }
    if (grid < 0) return;
    Params p{};
    p.x = (const float*)d_in[0]; p.meta = (const float*)d_in[1]; p.pre_g = (const float*)d_in[2]; p.w_in = (const float*)d_in[3];
    p.fox_b = (const float*)d_in[4]; p.qn_g = (const float*)d_in[5]; p.kvn_g = (const float*)d_in[6]; p.w_uq = (const float*)d_in[7];
    p.w_ukv = (const float*)d_in[8]; p.w_bm = (const float*)d_in[9]; p.w_bf = (const float*)d_in[10]; p.w_out = (const float*)d_in[11];
    p.post_g = (const float*)d_in[12];
    p.out = (float*)d_out; p.ws = (unsigned char*)d_ws;
#if MK_LAUNCHES == 1
    if (hipMemsetAsync((unsigned char*)d_ws + OFF_BAR, 0, XCD_BAR_WORDS * 4, stream) != hipSuccess) { fprintf(stderr, "kernel_launch: memset of the barrier words failed\n"); return; }
    int lo = 0, hi = 7;
    void* args[] = {&p, &lo, &hi};
    hipError_t e = hipLaunchCooperativeKernel((const void*)mega<true>, dim3(grid), dim3(NT), args, LDS_BYTES, stream);
    if (e != hipSuccess) fprintf(stderr, "cooperative launch failed: %s (grid %d)\n", hipGetErrorString(e), grid);
#else
    for (int ph = 0; ph <= 7; ++ph) hipLaunchKernelGGL(mega<false>, dim3(grid), dim3(NT), LDS_BYTES, stream, p, ph, ph);
#endif
}
```

```cpp
#include <hip/hip_runtime.h>
#include <hip/hip_cooperative_groups.h>
#include <cstdio>
#include <cstdint>
namespace cg = cooperative_groups;

#ifndef MK_LAUNCHES
#define MK_LAUNCHES 1
#endif
#ifndef PROBE_DUP
#define PROBE_DUP 0
#endif
#ifndef PROBE_MODE
#define PROBE_MODE 0
#endif

typedef unsigned short bf16_t;
typedef short bf16x8 __attribute__((ext_vector_type(8)));
typedef short s16x4 __attribute__((ext_vector_type(4)));
typedef float f32x16 __attribute__((ext_vector_type(16)));
typedef float f32x4 __attribute__((ext_vector_type(4)));
typedef float f32x2 __attribute__((ext_vector_type(2)));
typedef unsigned u32x4 __attribute__((ext_vector_type(4)));
typedef unsigned u32x2 __attribute__((ext_vector_type(2)));
typedef __bf16 bf2_t __attribute__((ext_vector_type(2)));

#define DI __device__ __forceinline__

constexpr int NT = 512;
constexpr int D = 1024, NB = 4, S = 4096, NMETA = 16, L = S + NMETA, T = NB * L;
constexpr int TP = 16640, LP = 4160, NH = 16;
constexpr float EPS = 1e-6f;
constexpr float LOG2E = 1.4426950408889634f;
constexpr float MLA_QS = (float)(1.4426950408889634 / 9.797958971132712);
constexpr float FOX_QS = (float)(1.4426950408889634 / 8.0);

constexpr size_t al256(size_t x) { return (x + 255) & ~(size_t)255; }
constexpr size_t OFF_CTRL = 0;
constexpr size_t OFF_BAR = 4096;
constexpr size_t OFF_SSQ = OFF_BAR + 16384;
constexpr size_t OFF_RSTD0 = OFF_SSQ + (size_t)NB * S * 4;
constexpr size_t OFF_ROPE = OFF_RSTD0 + al256((size_t)TP * 4);
constexpr size_t OFF_BIAS = OFF_ROPE + al256((size_t)LP * 32 * 4);
constexpr size_t OFF_FLOGIT = OFF_BIAS + al256((size_t)NB * NH * LP * 4);
constexpr size_t OFF_SSQC = OFF_FLOGIT + al256((size_t)TP * 16 * 4);
constexpr size_t OFF_RKV = OFF_SSQC + al256((size_t)TP * 4);
constexpr size_t OFF_WT1 = OFF_RKV + al256((size_t)TP * 4);
constexpr size_t OFF_WZ = OFF_WT1 + (size_t)3584 * 1024 * 2;
constexpr size_t OFF_WG = OFF_WZ + (size_t)2048 * 1024 * 2;
constexpr size_t OFF_WUQ = OFF_WG + (size_t)2048 * 1024 * 2;
constexpr size_t OFF_WUKV = OFF_WUQ + (size_t)1536 * 256 * 2;
constexpr size_t OFF_WBM = OFF_WUKV + (size_t)2048 * 128 * 2;
constexpr size_t OFF_WBF = OFF_WBM + (size_t)1024 * 1024 * 2;
constexpr size_t OFF_WOUT = OFF_WBF + (size_t)1024 * 1024 * 2;
constexpr size_t OFF_HB = OFF_WOUT + (size_t)1024 * 1024 * 2;
constexpr size_t OFF_FQ = OFF_HB + (size_t)TP * 1024 * 2;
constexpr size_t OFF_FK = OFF_FQ + (size_t)TP * 1024 * 2;
constexpr size_t OFF_QN = OFF_FK + (size_t)TP * 1024 * 2;
constexpr size_t OFF_QPE = OFF_QN + (size_t)TP * 1024 * 2;
constexpr size_t OFF_FVT = OFF_QPE + (size_t)TP * 512 * 2;
constexpr size_t OFF_VMT = OFF_FVT + (size_t)NB * NH * 64 * LP * 2;
constexpr size_t WS_END = OFF_VMT + (size_t)NB * NH * 64 * LP * 2;
static_assert(WS_END <= ((size_t)256 << 20), "workspace too large");
constexpr size_t OUT_KM = 0;
constexpr size_t OUT_CQ = OUT_KM + (size_t)TP * 1536 * 2;
constexpr size_t OUT_CKV = OUT_CQ + (size_t)TP * 256 * 2;
constexpr size_t OUT_KPE = OUT_CKV + (size_t)TP * 128 * 2;
static_assert(OUT_KPE + (size_t)TP * 32 * 4 <= (size_t)NB * S * D * 4, "d_out scratch too large");

struct Params {
    const float *x, *meta, *pre_g, *w_in, *fox_b, *qn_g, *kvn_g, *w_uq, *w_ukv, *w_bm, *w_bf, *w_out, *post_g;
    float* out;
    unsigned char* ws;
};

DI unsigned pk2(float lo, float hi) { f32x2 v = {lo, hi}; bf2_t b = __builtin_convertvector(v, bf2_t); return __builtin_bit_cast(unsigned, b); }
DI u32x2 pk4(float a, float b, float c, float d) { u32x2 r; r.x = pk2(a, b); r.y = pk2(c, d); return r; }
DI float bf_lo(unsigned u) { return __uint_as_float(u << 16); }
DI float bf_hi(unsigned u) { return __uint_as_float(u & 0xffff0000u); }
DI float fsigmoid(float z) { return __builtin_amdgcn_rcpf(1.0f + __expf(-z)); }
DI float fsilu(float z) { return z * fsigmoid(z); }
DI int crow(int r, int h) { return (r & 3) + 8 * (r >> 2) + 4 * h; }

#define XB_TMO      128
#define XB_XCNT(j)  (256  + 64 * (j))
#define XB_XSUB(j)  (1280 + 64 * (j))
#define XB_XGEN(j)  (2304 + 64 * (j))
#define XB_TOP      3328
#define XB_TOPGEN   3392
#define XCD_BAR_WORDS 3456
#define XB_SPIN_CAP (1u << 18)
#define LAS __attribute__((address_space(3)))
DI unsigned xb_ld(unsigned* p) { return __hip_atomic_load(p, __ATOMIC_RELAXED, __HIP_MEMORY_SCOPE_AGENT); }
DI unsigned xb_add(unsigned* p, unsigned v) { return __hip_atomic_fetch_add(p, v, __ATOMIC_RELAXED, __HIP_MEMORY_SCOPE_AGENT); }
DI unsigned xb_xcc_id() { return (unsigned)__builtin_amdgcn_s_getreg((3 << 11) | 20) & 0xFu; }
#define XB_SPIN(cond, bar) do { unsigned _sp = 0; while (cond) { __builtin_amdgcn_s_sleep(1); \
    if ((++_sp & 255u) == 0u) { if (xb_ld(&(bar)[XB_TMO])) break; if (_sp > XB_SPIN_CAP) { atomicAdd(&(bar)[XB_TMO], 1u); break; } } } } while (0)
struct XcdBarrier { unsigned* bar; unsigned x; volatile LAS unsigned* st; };
DI XcdBarrier xcd_barrier_post(unsigned* bar, volatile LAS unsigned* st) {
    XcdBarrier b; b.bar = bar; b.x = xb_xcc_id(); b.st = st;
    if (threadIdx.x == 0) (void)xb_add(&bar[XB_XCNT(b.x)], 1u);
    return b;
}
DI void xcd_barrier_complete(unsigned* bar, unsigned x, unsigned& nloc, unsigned& nx) {
    const unsigned G = gridDim.x * gridDim.y * gridDim.z;
    unsigned sum, cnt, mine, sp = 0u;
    for (;;) {
        sum = 0u; cnt = 0u; mine = 0u;
#pragma unroll
        for (unsigned j = 0; j < 16; ++j) { const unsigned c = xb_ld(&bar[XB_XCNT(j)]); sum += c; cnt += (c > 0u) ? 1u : 0u; mine = (j == x) ? c : mine; }
        if (sum == G) break;
        __builtin_amdgcn_s_sleep(1);
        if ((++sp & 255u) == 0u) { if (xb_ld(&bar[XB_TMO])) break; if (sp > XB_SPIN_CAP) { atomicAdd(&bar[XB_TMO], 1u); break; } }
    }
    nloc = mine > 0u ? mine : 1u; nx = cnt > 0u ? cnt : 1u;
}
DI void xcd_barrier(const XcdBarrier& b) {
    asm volatile("s_waitcnt vmcnt(0)" ::: "memory");
    __syncthreads();
    if (threadIdx.x == 0) {
        unsigned* bar = b.bar;
        __builtin_amdgcn_s_waitcnt(0);
        unsigned nloc = b.st[0], nx = b.st[1];
        if (nloc == 0u) { xcd_barrier_complete(bar, b.x, nloc, nx); b.st[0] = nloc; b.st[1] = nx; }
        const unsigned old = xb_add(&bar[XB_XSUB(b.x)], 1u);
        const unsigned gen = old / nloc;
        if (old + 1u == (gen + 1u) * nloc) {
            __builtin_amdgcn_fence(__ATOMIC_RELEASE, "agent");
            asm volatile("s_waitcnt vmcnt(0)" ::: "memory");
            const unsigned og = xb_add(&bar[XB_TOP], 1u);
            const unsigned tg = og / nx;
            if (og + 1u == (tg + 1u) * nx) xb_add(&bar[XB_TOPGEN], 1u);
            else XB_SPIN(xb_ld(&bar[XB_TOPGEN]) == tg, bar);
            __builtin_amdgcn_fence(__ATOMIC_ACQUIRE, "agent");
            xb_add(&bar[XB_XGEN(b.x)], 1u);
            asm volatile("s_waitcnt vmcnt(0)" ::: "memory");
        } else {
            XB_SPIN(xb_ld(&bar[XB_XGEN(b.x)]) == gen, bar);
            __builtin_amdgcn_fence(__ATOMIC_ACQUIRE, "agent");
            asm volatile("s_waitcnt vmcnt(0)" ::: "memory");
        }
    }
    __syncthreads();
}

constexpr int BK = 32, LROW = 80;
constexpr int LDS_MISC = 2048;
template <int WI, int WGJ> struct GC {
    static constexpr int WGI = 8 / WGJ, BI = WGI * WI * 32, BJ = WGJ * 64, STAGE = (BI + BJ) * LROW, NP = BI * 4 / NT, NQ = BJ * 4 / NT;
};
constexpr int LDS_BYTES = LDS_MISC + 3 * GC<4, 4>::STAGE;

template <int WI, int WGJ, int MODE = 0>
DI void gemm_tile2(const bf16_t* __restrict__ P, int ldp, const bf16_t* __restrict__ Q, int ldq, int K,
                  unsigned char* lds, f32x16 (&acc)[WI][2], int tid) {
    typedef GC<WI, WGJ> C;
    constexpr int NP = C::NP, NQ = C::NQ, STAGE = C::STAGE, BI = C::BI;
    const int lane = tid & 63, wid = tid >> 6, wi = wid / WGJ, wj = wid % WGJ;
    const int lrow = tid >> 2, lch = tid & 3;
    const bf16_t* pp = P + (size_t)lrow * ldp + lch * 8;
    const bf16_t* qp = Q + (size_t)lrow * ldq + lch * 8;
    unsigned char* wP = lds + lrow * LROW + lch * 16;
    const unsigned char* rP = lds + (wi * WI * 32 + (lane & 31)) * LROW + (lane >> 5) * 16;
    const unsigned char* rQ = lds + BI * LROW + (wj * 64 + (lane & 31)) * LROW + (lane >> 5) * 16;
    u32x4 pa[NP], qa[NQ], pb[NP], qb[NQ];
    bf16x8 fa0[WI], fb0[2], fa1[WI], fb1[2];
#pragma unroll
    for (int it = 0; it < WI; ++it)
#pragma unroll
        for (int jt = 0; jt < 2; ++jt)
#pragma unroll
            for (int r = 0; r < 16; ++r) acc[it][jt][r] = 0.f;
    const int nk = K / BK;
#define G_LOAD(pr, qr, kt_) if (MODE != 1) { _Pragma("unroll") for (int r = 0; r < NP; ++r) pr[r] = *(const u32x4*)(pp + (size_t)(r * 128) * ldp + (kt_) * BK); \
                              _Pragma("unroll") for (int r = 0; r < NQ; ++r) qr[r] = *(const u32x4*)(qp + (size_t)(r * 128) * ldq + (kt_) * BK); }
#define G_STORE(pr, qr, so_) { unsigned char* w_ = wP + (so_); \
                              _Pragma("unroll") for (int r = 0; r < NP; ++r) *(u32x4*)(w_ + r * 128 * LROW) = pr[r]; \
                              _Pragma("unroll") for (int r = 0; r < NQ; ++r) *(u32x4*)(w_ + BI * LROW + r * 128 * LROW) = qr[r]; }
#define F_LOAD(fa, fb, so_, ks_) { _Pragma("unroll") for (int it = 0; it < WI; ++it) fa[it] = *(const bf16x8*)(rP + (so_) + it * 32 * LROW + (ks_) * 32); \
                                  _Pragma("unroll") for (int jt = 0; jt < 2; ++jt) fb[jt] = *(const bf16x8*)(rQ + (so_) + jt * 32 * LROW + (ks_) * 32); }
#define G_MFMA(fa, fb) if (MODE != 2) { _Pragma("unroll") for (int it = 0; it < WI; ++it) _Pragma("unroll") for (int jt = 0; jt < 2; ++jt) \
                            acc[it][jt] = __builtin_amdgcn_mfma_f32_32x32x16_bf16(fa[it], fb[jt], acc[it][jt], 0, 0, 0); }
#define SB __builtin_amdgcn_sched_barrier(0);
    if (MODE == 1) {
#pragma unroll
        for (int r = 0; r < NP; ++r) { pa[r] = *(const u32x4*)(pp + (size_t)(r * 128) * ldp); pb[r] = pa[r]; }
#pragma unroll
        for (int r = 0; r < NQ; ++r) { qa[r] = *(const u32x4*)(qp + (size_t)(r * 128) * ldq); qb[r] = qa[r]; }
    }
    G_LOAD(pa, qa, 0)
    G_LOAD(pb, qb, 1)
    G_STORE(pa, qa, 0)
    G_LOAD(pa, qa, 2)
    G_STORE(pb, qb, STAGE)
    __syncthreads();
    F_LOAD(fa0, fb0, 0, 0)
    int cur = 0, nxt = STAGE, wr = 2 * STAGE;
#pragma unroll 1
    for (int kt = 0; kt < nk; kt += 2) {
        const int k3 = min(kt + 3, nk - 1), k4 = min(kt + 4, nk - 1);
        SB
        G_LOAD(pb, qb, k3)
        F_LOAD(fa1, fb1, cur, 1)
        SB
        G_MFMA(fa0, fb0)
        SB
        G_STORE(pa, qa, wr)
        F_LOAD(fa0, fb0, nxt, 0)
        SB
        G_MFMA(fa1, fb1)
        SB
        __syncthreads();
        { const int t_ = cur; cur = nxt; nxt = wr; wr = t_; }
        SB
        G_LOAD(pa, qa, k4)
        F_LOAD(fa1, fb1, cur, 1)
        SB
        G_MFMA(fa0, fb0)
        SB
        G_STORE(pb, qb, wr)
        F_LOAD(fa0, fb0, nxt, 0)
        SB
        G_MFMA(fa1, fb1)
        SB
        __syncthreads();
        { const int t_ = cur; cur = nxt; nxt = wr; wr = t_; }
    }
#undef G_LOAD
#undef G_STORE
#undef F_LOAD
#undef G_MFMA
#undef SB
}

template <int WI, int WGJ, int MODE = 0>
DI void gemm_tile3(const bf16_t* __restrict__ P, int ldp, const bf16_t* __restrict__ Q, int ldq, int K,
                  unsigned char* lds, f32x16 (&acc)[WI][2], int tid) {
    typedef GC<WI, WGJ> C;
    constexpr int NP = C::NP, NQ = C::NQ, STAGE = C::STAGE, BI = C::BI;
    const int lane = tid & 63, wid = tid >> 6, wi = wid / WGJ, wj = wid % WGJ;
    const int lrow = tid >> 2, lch = tid & 3;
    const bf16_t* pp = P + (size_t)lrow * ldp + lch * 8;
    const bf16_t* qp = Q + (size_t)lrow * ldq + lch * 8;
    unsigned char* wP = lds + lrow * LROW + lch * 16;
    const unsigned char* rP = lds + (wi * WI * 32 + (lane & 31)) * LROW + (lane >> 5) * 16;
    const unsigned char* rQ = lds + BI * LROW + (wj * 64 + (lane & 31)) * LROW + (lane >> 5) * 16;
    u32x4 p0[NP], q0[NQ], p1[NP], q1[NQ], p2[NP], q2[NQ];
    bf16x8 fa0[WI], fb0[2], fa1[WI], fb1[2];
#pragma unroll
    for (int it = 0; it < WI; ++it)
#pragma unroll
        for (int jt = 0; jt < 2; ++jt)
#pragma unroll
            for (int r = 0; r < 16; ++r) acc[it][jt][r] = 0.f;
    const int nk = K / BK;
#define G_LOAD(pr, qr, kt_) if (MODE != 1) { _Pragma("unroll") for (int r = 0; r < NP; ++r) pr[r] = *(const u32x4*)(pp + (size_t)(r * 128) * ldp + (kt_) * BK); \
                              _Pragma("unroll") for (int r = 0; r < NQ; ++r) qr[r] = *(const u32x4*)(qp + (size_t)(r * 128) * ldq + (kt_) * BK); }
#define G_STORE(pr, qr, so_) { unsigned char* w_ = wP + (so_); \
                              _Pragma("unroll") for (int r = 0; r < NP; ++r) *(u32x4*)(w_ + r * 128 * LROW) = pr[r]; \
                              _Pragma("unroll") for (int r = 0; r < NQ; ++r) *(u32x4*)(w_ + BI * LROW + r * 128 * LROW) = qr[r]; }
#define F_LOAD(fa, fb, so_, ks_) { _Pragma("unroll") for (int it = 0; it < WI; ++it) fa[it] = *(const bf16x8*)(rP + (so_) + it * 32 * LROW + (ks_) * 32); \
                                  _Pragma("unroll") for (int jt = 0; jt < 2; ++jt) fb[jt] = *(const bf16x8*)(rQ + (so_) + jt * 32 * LROW + (ks_) * 32); }
#define G_MFMA(fa, fb) if (MODE != 2) { _Pragma("unroll") for (int it = 0; it < WI; ++it) _Pragma("unroll") for (int jt = 0; jt < 2; ++jt) \
                            acc[it][jt] = __builtin_amdgcn_mfma_f32_32x32x16_bf16(fa[it], fb[jt], acc[it][jt], 0, 0, 0); }
#define SB __builtin_amdgcn_sched_barrier(0);
#define G_HALF(pl, ql, ps, qs, kt_) { const int k4_ = min((kt_) + 4, nk - 1); \
        SB G_LOAD(pl, ql, k4_) F_LOAD(fa1, fb1, cur, 1) SB G_MFMA(fa0, fb0) SB G_STORE(ps, qs, wr) F_LOAD(fa0, fb0, nxt, 0) SB G_MFMA(fa1, fb1) SB \
        __syncthreads(); { const int t_ = cur; cur = nxt; nxt = wr; wr = t_; } }
    if (MODE == 1) {
#pragma unroll
        for (int r = 0; r < NP; ++r) { p0[r] = *(const u32x4*)(pp + (size_t)(r * 128) * ldp); p1[r] = p0[r]; p2[r] = p0[r]; }
#pragma unroll
        for (int r = 0; r < NQ; ++r) { q0[r] = *(const u32x4*)(qp + (size_t)(r * 128) * ldq); q1[r] = q0[r]; q2[r] = q0[r]; }
    }
    G_LOAD(p0, q0, 0)
    G_LOAD(p1, q1, 1)
    G_LOAD(p2, q2, 2)
    G_STORE(p0, q0, 0)
    G_LOAD(p0, q0, 3)
    G_STORE(p1, q1, STAGE)
    __syncthreads();
    F_LOAD(fa0, fb0, 0, 0)
    int cur = 0, nxt = STAGE, wr = 2 * STAGE;
    int kt = 0;
#pragma unroll 1
    for (; kt + 3 <= nk; kt += 3) {
        G_HALF(p1, q1, p2, q2, kt)
        G_HALF(p2, q2, p0, q0, kt + 1)
        G_HALF(p0, q0, p1, q1, kt + 2)
    }
    if (kt < nk) G_HALF(p1, q1, p2, q2, kt)
    if (kt + 1 < nk) G_HALF(p2, q2, p0, q0, kt + 1)
#undef G_HALF
#undef G_LOAD
#undef G_STORE
#undef F_LOAD
#undef G_MFMA
#undef SB
}

template <int WI, int WGJ, int MODE = 0, bool ZERO = true>
DI void gemm_tile3r(const bf16_t* __restrict__ P, int ldp, const bf16_t* __restrict__ Q, int ldq, int K,
                  unsigned char* lds, f32x16 (&acc)[WI][2], int tid) {
    typedef GC<WI, WGJ> C;
    constexpr int NP = C::NP, NQ = C::NQ, STAGE = C::STAGE, BI = C::BI;
    const int lane = tid & 63, wid = tid >> 6, wi = wid / WGJ, wj = wid % WGJ;
    const int lrow = tid >> 2, lch = tid & 3;
    const bf16_t* pp = P + (size_t)lrow * ldp + lch * 8;
    const bf16_t* qp = Q + (size_t)lrow * ldq + lch * 8;
    unsigned char* wP = lds + lrow * LROW + lch * 16;
    const unsigned char* rP = lds + (wi * WI * 32 + (lane & 31)) * LROW + (lane >> 5) * 16;
    const unsigned char* rQ = lds + BI * LROW + (wj * 64 + (lane & 31)) * LROW + (lane >> 5) * 16;
    u32x4 p0[NP], q0[NQ], p1[NP], q1[NQ], p2[NP], q2[NQ];
    bf16x8 fa0[WI], fb0[2], fb1[2];
    if (ZERO) {
#pragma unroll
        for (int it = 0; it < WI; ++it)
#pragma unroll
            for (int jt = 0; jt < 2; ++jt)
#pragma unroll
                for (int r = 0; r < 16; ++r) acc[it][jt][r] = 0.f;
    }
    const int nk = K / BK;
#define G_LOAD(pr, qr, kt_) if (MODE != 1) { _Pragma("unroll") for (int r = 0; r < NP; ++r) pr[r] = *(const u32x4*)(pp + (size_t)(r * 128) * ldp + (kt_) * BK); \
                              _Pragma("unroll") for (int r = 0; r < NQ; ++r) qr[r] = *(const u32x4*)(qp + (size_t)(r * 128) * ldq + (kt_) * BK); }
#define G_STORE(pr, qr, so_) { unsigned char* w_ = wP + (so_); \
                              _Pragma("unroll") for (int r = 0; r < NP; ++r) *(u32x4*)(w_ + r * 128 * LROW) = pr[r]; \
                              _Pragma("unroll") for (int r = 0; r < NQ; ++r) *(u32x4*)(w_ + BI * LROW + r * 128 * LROW) = qr[r]; }
#define F_LOAD(fa, fb, so_, ks_) { _Pragma("unroll") for (int it = 0; it < WI; ++it) fa[it] = *(const bf16x8*)(rP + (so_) + it * 32 * LROW + (ks_) * 32); \
                                  _Pragma("unroll") for (int jt = 0; jt < 2; ++jt) fb[jt] = *(const bf16x8*)(rQ + (so_) + jt * 32 * LROW + (ks_) * 32); }
#define G_MFMA(fa, fb) if (MODE != 2) { _Pragma("unroll") for (int it = 0; it < WI; ++it) _Pragma("unroll") for (int jt = 0; jt < 2; ++jt) \
                            acc[it][jt] = __builtin_amdgcn_mfma_f32_32x32x16_bf16(fa[it], fb[jt], acc[it][jt], 0, 0, 0); }
#define SB __builtin_amdgcn_sched_barrier(0);
#define A_LD(it_, so_, ks_) fa0[it_] = *(const bf16x8*)(rP + (so_) + (it_) * 32 * LROW + (ks_) * 32);
#define B_LD(fb, so_, ks_) { _Pragma("unroll") for (int jt = 0; jt < 2; ++jt) fb[jt] = *(const bf16x8*)(rQ + (so_) + jt * 32 * LROW + (ks_) * 32); }
#define X_LOAD(it_, pl, ql, kt_) if (MODE != 1) { if ((it_) < NP) pl[(it_) < NP ? (it_) : 0] = *(const u32x4*)(pp + (size_t)(((it_) < NP ? (it_) : 0) * 128) * ldp + (kt_) * BK); \
                                  else ql[(it_) >= NP ? (it_) - NP : 0] = *(const u32x4*)(qp + (size_t)(((it_) >= NP ? (it_) - NP : 0) * 128) * ldq + (kt_) * BK); }
#define X_STORE(it_, ps, qs, so_) { if ((it_) < NP) *(u32x4*)(wP + (so_) + ((it_) < NP ? (it_) : 0) * 128 * LROW) = ps[(it_) < NP ? (it_) : 0]; \
                                   else *(u32x4*)(wP + (so_) + BI * LROW + ((it_) >= NP ? (it_) - NP : 0) * 128 * LROW) = qs[(it_) >= NP ? (it_) - NP : 0]; }
#define B_LD1(fbn, jt_, so_, ks_) fbn[jt_] = *(const bf16x8*)(rQ + (so_) + (jt_) * 32 * LROW + (ks_) * 32);
#define R_BURST1(fb, fbn, so_, ks_, pl, ql, kt_, ps, qs, wo_) { _Pragma("unroll") for (int it = 0; it < WI; ++it) { \
            acc[it][0] = __builtin_amdgcn_mfma_f32_32x32x16_bf16(fa0[it], fb[0], acc[it][0], 0, 0, 0); SB \
            if (it < 2) B_LD1(fbn, it < 2 ? it : 0, so_, ks_) X_STORE(it, ps, qs, wo_) SB \
            acc[it][1] = __builtin_amdgcn_mfma_f32_32x32x16_bf16(fa0[it], fb[1], acc[it][1], 0, 0, 0); SB A_LD(it, so_, ks_) X_LOAD(it, pl, ql, kt_) SB } }
#define R_BURST2(fb, fbn, so_, ks_, ps, qs, wo_) { _Pragma("unroll") for (int it = 0; it < WI; ++it) { \
            acc[it][0] = __builtin_amdgcn_mfma_f32_32x32x16_bf16(fa0[it], fb[0], acc[it][0], 0, 0, 0); SB \
            if (it < 2) B_LD1(fbn, it < 2 ? it : 0, so_, ks_) SB \
            acc[it][1] = __builtin_amdgcn_mfma_f32_32x32x16_bf16(fa0[it], fb[1], acc[it][1], 0, 0, 0); SB A_LD(it, so_, ks_) SB } }
#define G_HALF(pl, ql, ps, qs, kt_) { const int k4_ = min((kt_) + 4, nk - 1); \
        SB R_BURST1(fb0, fb1, cur, 1, pl, ql, k4_, ps, qs, wr) R_BURST2(fb1, fb0, nxt, 0, ps, qs, wr) \
        __syncthreads(); { const int t_ = cur; cur = nxt; nxt = wr; wr = t_; } }
    if (MODE == 1) {
#pragma unroll
        for (int r = 0; r < NP; ++r) { p0[r] = *(const u32x4*)(pp + (size_t)(r * 128) * ldp); p1[r] = p0[r]; p2[r] = p0[r]; }
#pragma unroll
        for (int r = 0; r < NQ; ++r) { q0[r] = *(const u32x4*)(qp + (size_t)(r * 128) * ldq); q1[r] = q0[r]; q2[r] = q0[r]; }
    }
    G_LOAD(p0, q0, 0)
    G_LOAD(p1, q1, 1)
    G_LOAD(p2, q2, 2)
    G_STORE(p0, q0, 0)
    G_LOAD(p0, q0, 3)
    G_STORE(p1, q1, STAGE)
    __syncthreads();
    F_LOAD(fa0, fb0, 0, 0)
    int cur = 0, nxt = STAGE, wr = 2 * STAGE;
    int kt = 0;
#pragma unroll 1
    for (; kt + 3 <= nk; kt += 3) {
        G_HALF(p1, q1, p2, q2, kt)
        G_HALF(p2, q2, p0, q0, kt + 1)
        G_HALF(p0, q0, p1, q1, kt + 2)
    }
    if (kt < nk) G_HALF(p1, q1, p2, q2, kt)
    if (kt + 1 < nk) G_HALF(p2, q2, p0, q0, kt + 1)
#undef G_HALF
#undef A_LD
#undef B_LD
#undef B_LD1
#undef R_BURST1
#undef R_BURST2
#undef X_LOAD
#undef X_STORE
#undef G_LOAD
#undef G_STORE
#undef F_LOAD
#undef G_MFMA
#undef SB
}
struct GSets { u32x4 p0[2], q0[2], p1[2], q1[2], p2[2], q2[2]; };
DI void gemm_issue(const bf16_t* __restrict__ P, const bf16_t* __restrict__ Q, GSets& g, int tid) {
    const bf16_t* pp = P + (size_t)(tid >> 2) * 1024 + (tid & 3) * 8;
    const bf16_t* qp = Q + (size_t)(tid >> 2) * 1024 + (tid & 3) * 8;
#pragma unroll
    for (int r = 0; r < 2; ++r) { g.p0[r] = *(const u32x4*)(pp + (size_t)(r * 128) * 1024); g.q0[r] = *(const u32x4*)(qp + (size_t)(r * 128) * 1024); }
#pragma unroll
    for (int r = 0; r < 2; ++r) { g.p1[r] = *(const u32x4*)(pp + (size_t)(r * 128) * 1024 + BK); g.q1[r] = *(const u32x4*)(qp + (size_t)(r * 128) * 1024 + BK); }
#pragma unroll
    for (int r = 0; r < 2; ++r) { g.p2[r] = *(const u32x4*)(pp + (size_t)(r * 128) * 1024 + 2 * BK); g.q2[r] = *(const u32x4*)(qp + (size_t)(r * 128) * 1024 + 2 * BK); }
}
template <int WI, int WGJ, int MODE = 0, bool ZERO = true>
DI void gemm_tile3p(const bf16_t* __restrict__ P, int ldp, const bf16_t* __restrict__ Q, int ldq,
                  unsigned char* lds, f32x16 (&acc)[WI][2], int tid, GSets& g) {
    typedef GC<WI, WGJ> C;
    constexpr int NP = C::NP, NQ = C::NQ, STAGE = C::STAGE, BI = C::BI;
    const int lane = tid & 63, wid = tid >> 6, wi = wid / WGJ, wj = wid % WGJ;
    const int lrow = tid >> 2, lch = tid & 3;
    const bf16_t* pp = P + (size_t)lrow * ldp + lch * 8;
    const bf16_t* qp = Q + (size_t)lrow * ldq + lch * 8;
    unsigned char* wP = lds + lrow * LROW + lch * 16;
    const unsigned char* rP = lds + (wi * WI * 32 + (lane & 31)) * LROW + (lane >> 5) * 16;
    const unsigned char* rQ = lds + BI * LROW + (wj * 64 + (lane & 31)) * LROW + (lane >> 5) * 16;
    static_assert(WI == 4 && WGJ == 4, "prefetching core: 256 x 256 tiles only");
    u32x4 (&p0)[2] = g.p0, (&q0)[2] = g.q0, (&p1)[2] = g.p1, (&q1)[2] = g.q1, (&p2)[2] = g.p2, (&q2)[2] = g.q2;
    bf16x8 fa0[WI], fb0[2], fb1[2];
    if (ZERO) {
#pragma unroll
        for (int it = 0; it < WI; ++it)
#pragma unroll
            for (int jt = 0; jt < 2; ++jt)
#pragma unroll
                for (int r = 0; r < 16; ++r) acc[it][jt][r] = 0.f;
    }
    constexpr int nk = 1024 / BK;
#define G_LOAD(pr, qr, kt_) if (MODE != 1) { _Pragma("unroll") for (int r = 0; r < NP; ++r) pr[r] = *(const u32x4*)(pp + (size_t)(r * 128) * ldp + (kt_) * BK); \
                              _Pragma("unroll") for (int r = 0; r < NQ; ++r) qr[r] = *(const u32x4*)(qp + (size_t)(r * 128) * ldq + (kt_) * BK); }
#define G_STORE(pr, qr, so_) { unsigned char* w_ = wP + (so_); \
                              _Pragma("unroll") for (int r = 0; r < NP; ++r) *(u32x4*)(w_ + r * 128 * LROW) = pr[r]; \
                              _Pragma("unroll") for (int r = 0; r < NQ; ++r) *(u32x4*)(w_ + BI * LROW + r * 128 * LROW) = qr[r]; }
#define F_LOAD(fa, fb, so_, ks_) { _Pragma("unroll") for (int it = 0; it < WI; ++it) fa[it] = *(const bf16x8*)(rP + (so_) + it * 32 * LROW + (ks_) * 32); \
                                  _Pragma("unroll") for (int jt = 0; jt < 2; ++jt) fb[jt] = *(const bf16x8*)(rQ + (so_) + jt * 32 * LROW + (ks_) * 32); }
#define G_MFMA(fa, fb) if (MODE != 2) { _Pragma("unroll") for (int it = 0; it < WI; ++it) _Pragma("unroll") for (int jt = 0; jt < 2; ++jt) \
                            acc[it][jt] = __builtin_amdgcn_mfma_f32_32x32x16_bf16(fa[it], fb[jt], acc[it][jt], 0, 0, 0); }
#define SB __builtin_amdgcn_sched_barrier(0);
#define A_LD(it_, so_, ks_) fa0[it_] = *(const bf16x8*)(rP + (so_) + (it_) * 32 * LROW + (ks_) * 32);
#define B_LD(fb, so_, ks_) { _Pragma("unroll") for (int jt = 0; jt < 2; ++jt) fb[jt] = *(const bf16x8*)(rQ + (so_) + jt * 32 * LROW + (ks_) * 32); }
#define X_LOAD(it_, pl, ql, kt_) if (MODE != 1) { if ((it_) < NP) pl[(it_) < NP ? (it_) : 0] = *(const u32x4*)(pp + (size_t)(((it_) < NP ? (it_) : 0) * 128) * ldp + (kt_) * BK); \
                                  else ql[(it_) >= NP ? (it_) - NP : 0] = *(const u32x4*)(qp + (size_t)(((it_) >= NP ? (it_) - NP : 0) * 128) * ldq + (kt_) * BK); }
#define X_STORE(it_, ps, qs, so_) { if ((it_) < NP) *(u32x4*)(wP + (so_) + ((it_) < NP ? (it_) : 0) * 128 * LROW) = ps[(it_) < NP ? (it_) : 0]; \
                                   else *(u32x4*)(wP + (so_) + BI * LROW + ((it_) >= NP ? (it_) - NP : 0) * 128 * LROW) = qs[(it_) >= NP ? (it_) - NP : 0]; }
#define B_LD1(fbn, jt_, so_, ks_) fbn[jt_] = *(const bf16x8*)(rQ + (so_) + (jt_) * 32 * LROW + (ks_) * 32);
#define R_BURST1(fb, fbn, so_, ks_, pl, ql, kt_, ps, qs, wo_) { _Pragma("unroll") for (int it = 0; it < WI; ++it) { \
            acc[it][0] = __builtin_amdgcn_mfma_f32_32x32x16_bf16(fa0[it], fb[0], acc[it][0], 0, 0, 0); SB \
            if (it < 2) B_LD1(fbn, it < 2 ? it : 0, so_, ks_) X_STORE(it, ps, qs, wo_) SB \
            acc[it][1] = __builtin_amdgcn_mfma_f32_32x32x16_bf16(fa0[it], fb[1], acc[it][1], 0, 0, 0); SB A_LD(it, so_, ks_) X_LOAD(it, pl, ql, kt_) SB } }
#define R_BURST2(fb, fbn, so_, ks_, ps, qs, wo_) { _Pragma("unroll") for (int it = 0; it < WI; ++it) { \
            acc[it][0] = __builtin_amdgcn_mfma_f32_32x32x16_bf16(fa0[it], fb[0], acc[it][0], 0, 0, 0); SB \
            if (it < 2) B_LD1(fbn, it < 2 ? it : 0, so_, ks_) SB \
            acc[it][1] = __builtin_amdgcn_mfma_f32_32x32x16_bf16(fa0[it], fb[1], acc[it][1], 0, 0, 0); SB A_LD(it, so_, ks_) SB } }
#define G_HALF(pl, ql, ps, qs, kt_) { const int k4_ = min((kt_) + 4, nk - 1); \
        SB R_BURST1(fb0, fb1, cur, 1, pl, ql, k4_, ps, qs, wr) R_BURST2(fb1, fb0, nxt, 0, ps, qs, wr) \
        __syncthreads(); { const int t_ = cur; cur = nxt; nxt = wr; wr = t_; } }
#define R_BURST1N(fb, fbn, so_, ks_) { _Pragma("unroll") for (int it = 0; it < WI; ++it) { \
            acc[it][0] = __builtin_amdgcn_mfma_f32_32x32x16_bf16(fa0[it], fb[0], acc[it][0], 0, 0, 0); SB \
            if (it < 2) B_LD1(fbn, it < 2 ? it : 0, so_, ks_) SB \
            acc[it][1] = __builtin_amdgcn_mfma_f32_32x32x16_bf16(fa0[it], fb[1], acc[it][1], 0, 0, 0); SB A_LD(it, so_, ks_) SB } }
#define R_BURST1S(fb, fbn, so_, ks_, ps, qs, wo_) { _Pragma("unroll") for (int it = 0; it < WI; ++it) { \
            acc[it][0] = __builtin_amdgcn_mfma_f32_32x32x16_bf16(fa0[it], fb[0], acc[it][0], 0, 0, 0); SB \
            if (it < 2) B_LD1(fbn, it < 2 ? it : 0, so_, ks_) X_STORE(it, ps, qs, wo_) SB \
            acc[it][1] = __builtin_amdgcn_mfma_f32_32x32x16_bf16(fa0[it], fb[1], acc[it][1], 0, 0, 0); SB A_LD(it, so_, ks_) SB } }
#define G_HALF_NL(ps, qs, kt_) { SB R_BURST1S(fb0, fb1, cur, 1, ps, qs, wr) R_BURST2(fb1, fb0, nxt, 0, ps, qs, wr) \
        __syncthreads(); { const int t_ = cur; cur = nxt; nxt = wr; wr = t_; } }
#define G_HALF_NN(kt_) { SB R_BURST1N(fb0, fb1, cur, 1) R_BURST1N(fb1, fb0, nxt, 0) \
        __syncthreads(); { const int t_ = cur; cur = nxt; nxt = wr; wr = t_; } }
    G_STORE(p0, q0, 0)
    G_LOAD(p0, q0, 3)
    G_STORE(p1, q1, STAGE)
    __syncthreads();
    F_LOAD(fa0, fb0, 0, 0)
    int cur = 0, nxt = STAGE, wr = 2 * STAGE;
    int kt = 0;
#pragma unroll 1
    for (; kt + 3 <= nk - 4; kt += 3) {
        G_HALF(p1, q1, p2, q2, kt)
        G_HALF(p2, q2, p0, q0, kt + 1)
        G_HALF(p0, q0, p1, q1, kt + 2)
    }
    G_HALF(p1, q1, p2, q2, nk - 5)
    G_HALF_NL(p0, q0, nk - 4)
    G_HALF_NL(p1, q1, nk - 3)
    G_HALF_NN(nk - 2)
    G_HALF_NN(nk - 1)
#undef G_HALF
#undef G_HALF_NL
#undef G_HALF_NN
#undef R_BURST1N
#undef R_BURST1S
#undef A_LD
#undef B_LD
#undef B_LD1
#undef R_BURST1
#undef R_BURST2
#undef X_LOAD
#undef X_STORE
#undef G_LOAD
#undef G_STORE
#undef F_LOAD
#undef G_MFMA
#undef SB
}

template <int WI, int WGJ, class GetF, class FinF>
DI void staged_rows(unsigned char* lds, int tid, GetF get, FinF fin) {
    constexpr int WGI = 8 / WGJ, BI = WGI * WI * 32, RS = BI * 2 + 16, ROWS = WGJ * 32, NCH = BI / 8;
    const int lane = tid & 63, wid = tid >> 6, wi = wid / WGJ, wj = wid % WGJ, h = lane >> 5, ln = lane & 31;
#pragma unroll
    for (int jt = 0; jt < 2; ++jt) {
        unsigned char* wrow = lds + (wj * 32 + ln) * RS + (wi * WI * 32 + 4 * h) * 2;
#pragma unroll
        for (int it = 0; it < WI; ++it)
#pragma unroll
            for (int g = 0; g < 4; ++g) *(u32x2*)(wrow + (it * 32 + 8 * g) * 2) = get(it, jt, g);
        __syncthreads();
#pragma unroll 1
        for (int c = 0; c < ROWS * NCH / NT; ++c) {
            const int idx = tid + c * NT, lr = idx / NCH, ch = idx % NCH;
            const u32x4 v = *(const u32x4*)(lds + lr * RS + ch * 16);
            fin((lr >> 5) * 64 + jt * 32 + (lr & 31), ch * 8, v);
        }
        __syncthreads();
    }
}

struct X8 { f32x4 a, b; };
template <int WI, int WGJ, class GetF, class LdF, class FinF>
DI void staged_rows_rmw(unsigned char* lds, int tid, GetF get, LdF ld, FinF fin) {
    constexpr int WGI = 8 / WGJ, BI = WGI * WI * 32, RS = BI * 2 + 16, ROWS = WGJ * 32, NCH = BI / 8, NIT = ROWS * NCH / NT;
    const int lane = tid & 63, wid = tid >> 6, wi = wid / WGJ, wj = wid % WGJ, h = lane >> 5, ln = lane & 31;
#pragma unroll
    for (int jt = 0; jt < 2; ++jt) {
        unsigned char* wrow = lds + (wj * 32 + ln) * RS + (wi * WI * 32 + 4 * h) * 2;
#pragma unroll
        for (int it = 0; it < WI; ++it)
#pragma unroll
            for (int g = 0; g < 4; ++g) *(u32x2*)(wrow + (it * 32 + 8 * g) * 2) = get(it, jt, g);
        constexpr int NGRP = 2, GSZ = NIT / NGRP;
        __syncthreads();
#pragma unroll 1
        for (int gq = 0; gq < NGRP; ++gq) {
            decltype(ld(0, 0)) fetched[GSZ];
#pragma unroll
            for (int c = 0; c < GSZ; ++c) {
                const int idx = tid + (gq * GSZ + c) * NT, lr = idx / NCH, ch = idx % NCH;
                fetched[c] = ld((lr >> 5) * 64 + jt * 32 + (lr & 31), ch * 8);
            }
#pragma unroll
            for (int c = 0; c < GSZ; ++c) {
                const int idx = tid + (gq * GSZ + c) * NT, lr = idx / NCH, ch = idx % NCH;
                const u32x4 v = *(const u32x4*)(lds + lr * RS + ch * 16);
                fin((lr >> 5) * 64 + jt * 32 + (lr & 31), ch * 8, v, fetched[c]);
            }
        }
        __syncthreads();
    }
}

template <int NROWS, int NCOLS>
DI void tile_rstd(const bf16_t* base, int ld, float* out, int tid) {
    constexpr int TPR = NT / NROWS, PER = NCOLS / TPR;
    const int row = tid / TPR, part = tid % TPR;
    const bf16_t* p = base + (size_t)row * ld + part * PER;
    float s = 0.f;
#pragma unroll
    for (int c = 0; c < PER / 8; ++c) {
        u32x4 v = *(const u32x4*)(p + c * 8);
#pragma unroll
        for (int e = 0; e < 4; ++e) { float a = bf_lo(v[e]), b = bf_hi(v[e]); s += a * a + b * b; }
    }
    s += __shfl_xor(s, 1);
    if (TPR == 4) s += __shfl_xor(s, 2);
    if (part == 0) out[row] = 1.0f / sqrtf(s * (1.0f / NCOLS) + EPS);
}

DI void sincos_acc(float angf, float& c, float& s) {
    const double a = (double)angf;
    const double kd = rint(a * 0.6366197723675814);
    double r = fma(-kd, 1.5707963267948966, a);
    r = fma(-kd, 6.123233995736766e-17, r);
    const int k = (int)kd;
    const double r2 = r * r;
    const double sp = r * (1.0 + r2 * (-1.0 / 6 + r2 * (1.0 / 120 + r2 * (-1.0 / 5040 + r2 * (1.0 / 362880 + r2 * (-1.0 / 39916800))))));
    const double cp = 1.0 + r2 * (-0.5 + r2 * (1.0 / 24 + r2 * (-1.0 / 720 + r2 * (1.0 / 40320 + r2 * (-1.0 / 3628800 + r2 * (1.0 / 479001600))))));
    const int q = k & 3;
    const double ss = (q == 0) ? sp : (q == 1) ? cp : (q == 2) ? -sp : -cp;
    const double cc = (q == 0) ? cp : (q == 1) ? -sp : (q == 2) ? -cp : sp;
    c = (float)cc; s = (float)ss;
}

DI void transpose_tile(bf16_t* dst, int dst_ld, int n0, int nvalid, int nwrite, const float* src, int src_ld, int col0, int k0,
                       const float* gain, float* ldsf, int tid) {
    if (nvalid > 0) {
#pragma unroll
        for (int r = 0; r < 2; ++r) {
            const int c = tid + NT * r, kk = c >> 4, n4 = (c & 15) * 4;
            f32x4 v = __builtin_nontemporal_load((const f32x4*)(src + (size_t)(k0 + kk) * src_ld + col0 + n4));
            const float g = gain ? gain[k0 + kk] : 1.0f;
            float* d = ldsf + kk * 65 + n4;
            d[0] = v[0] * g; d[1] = v[1] * g; d[2] = v[2] * g; d[3] = v[3] * g;
        }
    }
    __syncthreads();
    const int n = tid >> 3, kc = tid & 7;
    if (n < nwrite) {
        u32x4 w = {0u, 0u, 0u, 0u};
        if (n < nvalid) {
            const float* s = ldsf + (kc * 8) * 65 + n;
            w[0] = pk2(s[0], s[65]); w[1] = pk2(s[130], s[195]); w[2] = pk2(s[260], s[325]); w[3] = pk2(s[390], s[455]);
        }
        *(u32x4*)(dst + (size_t)(n0 + n) * dst_ld + k0 + kc * 8) = w;
    }
    __syncthreads();
}

constexpr int WJ0 = 64, WJ1 = WJ0 + 768, WJ2 = WJ1 + 32, WJ3 = WJ2 + 16, WJ4 = WJ3 + 16, WJ5 = WJ4 + 16, WJ6 = WJ5 + 256, WJ7 = WJ6 + 256,
              WJ8 = WJ7 + 512, WJ9 = WJ8 + 96, WJ10 = WJ9 + 64, WJ11 = WJ10 + 256, WJ12 = WJ11 + 256, WJ13 = WJ12 + 256;
constexpr int W_EARLY = WJ5, W_ALL = WJ13;
DI void weight_tile(const Params& p, int id, float* ldsf, int tid) {
    unsigned char* ws = p.ws;
    bf16_t* wt1 = (bf16_t*)(ws + OFF_WT1);
    bf16_t* wz = (bf16_t*)(ws + OFF_WZ);
    bf16_t* wg = (bf16_t*)(ws + OFF_WG);
    if (id < WJ5) {
        int nt, kt, n0, nvalid = 64, nwrite = 64, col0;
        if (id < WJ0) { nt = id >> 4; kt = id & 15; n0 = nt * 64; col0 = nt * 64; }
        else if (id < WJ1) { const int j = id - WJ0; nt = j >> 4; kt = j & 15; n0 = 256 + nt * 64; col0 = 1440 + nt * 64; }
        else if (id < WJ2) { const int j = id - WJ1; nt = j >> 4; kt = j & 15; n0 = 3328 + nt * 64; col0 = 256 + nt * 64; }
        else if (id < WJ3) { kt = id - WJ2; n0 = 3456; col0 = 384; nvalid = 32; nwrite = 32; }
        else if (id < WJ4) { kt = id - WJ3; n0 = 3488; col0 = 4512; nvalid = 16; nwrite = 64; }
        else { kt = id - WJ4; n0 = 3552; col0 = 0; nvalid = 0; nwrite = 32; }
        transpose_tile(wt1, 1024, n0, nvalid, nwrite, p.w_in, 7600, col0, kt * 64, p.pre_g, ldsf, tid);
    } else if (id < WJ6) { const int j = id - WJ5; transpose_tile(wz, 1024, (j >> 4) * 64, 64, 64, p.w_in, 7600, 416 + (j >> 4) * 64, (j & 15) * 64, p.pre_g, ldsf, tid); }
    else if (id < WJ7) { const int j = id - WJ6; transpose_tile(wz, 1024, 1024 + (j >> 4) * 64, 64, 64, p.w_in, 7600, 4528 + (j >> 4) * 64, (j & 15) * 64, p.pre_g, ldsf, tid); }
    else if (id < WJ8) { const int j = id - WJ7; transpose_tile(wg, 1024, (j >> 4) * 64, 64, 64, p.w_in, 7600, 5552 + (j >> 4) * 64, (j & 15) * 64, p.pre_g, ldsf, tid); }
    else if (id < WJ9) { const int j = id - WJ8; transpose_tile((bf16_t*)(ws + OFF_WUQ), 256, (j >> 2) * 64, 64, 64, p.w_uq, 1536, (j >> 2) * 64, (j & 3) * 64, p.qn_g, ldsf, tid); }
    else if (id < WJ10) { const int j = id - WJ9; const int nt = j >> 1; const int col0 = nt < 16 ? nt * 128 : (nt - 16) * 128 + 64;
        transpose_tile((bf16_t*)(ws + OFF_WUKV), 128, nt * 64, 64, 64, p.w_ukv, 2048, col0, (j & 1) * 64, p.kvn_g, ldsf, tid); }
    else {
        const int j = id - WJ10; const int which = j >> 8, jj = j & 255;
        const float* src = which == 0 ? p.w_bm : which == 1 ? p.w_bf : p.w_out;
        bf16_t* dst = (bf16_t*)(ws + (which == 0 ? OFF_WBM : which == 1 ? OFF_WBF : OFF_WOUT));
        transpose_tile(dst, 1024, (jj >> 4) * 64, 64, 64, src, 1024, (jj >> 4) * 64, (jj & 15) * 64, nullptr, ldsf, tid);
    }
}

DI void phase0(const Params& p, unsigned char* smem, int tid) {
    unsigned char* ws = p.ws;
    const int bid = blockIdx.x, nblk = gridDim.x;
    const int gtid = bid * NT + tid, gsz = nblk * NT;
    if (bid == 0 && tid < 256) ((unsigned*)(ws + OFF_CTRL))[tid] = 0u;
    for (int i = gtid; i < NB * S; i += gsz) ((float*)(ws + OFF_SSQ))[i] = 0.f;
    for (int i = gtid; i < TP; i += gsz) ((float*)(ws + OFF_SSQC))[i] = 0.f;
    for (int i = gtid; i < LP * 16; i += gsz) {
        const int l = i >> 4, f = i & 15;
        const int fl = f & 3, fh = f >> 2;
        const double bd = fl == 0 ? 1.0 : fl == 1 ? 0.5623413251903491 : fl == 2 ? 0.31622776601683794 : 0.1778279410038923;
        const double sd = fh == 0 ? 1.0 : fh == 1 ? 0.1 : fh == 2 ? 0.01 : 0.001;
        const float invf = (float)(bd * sd);
        const float ang = (float)l * invf;
        float c, s; sincos_acc(ang, c, s);
        float* rp = (float*)(ws + OFF_ROPE);
        rp[l * 32 + f] = c; rp[l * 32 + 16 + f] = s;
    }
    for (int i = gtid; i < 2 * NB * NH * 64 * 12; i += gsz) {
        const int c = i % 12, row = i / 12;
        *(u32x2*)(ws + OFF_FVT + (size_t)row * (LP * 2) + L * 2 + c * 8) = (u32x2){0u, 0u};
    }
    {
        const int lane = tid & 63, gw = bid * (NT / 64) + (tid >> 6), nw = nblk * (NT / 64);
        bf16_t* hb = (bf16_t*)(ws + OFF_HB);
        float* rstd = (float*)(ws + OFF_RSTD0);
        for (int t = gw; t < TP; t += nw) {
            if (t < T) {
                const int b = t / L, l = t - b * L;
                const float* src = (l < NMETA) ? (p.meta + (size_t)l * D) : (p.x + ((size_t)b * S + (l - NMETA)) * D);
                float ss = 0.f;
#pragma unroll
                for (int c = 0; c < 4; ++c) {
                    f32x4 v = __builtin_nontemporal_load((const f32x4*)(src + (c * 64 + lane) * 4));
                    ss += v[0] * v[0] + v[1] * v[1] + v[2] * v[2] + v[3] * v[3];
                    *(u32x2*)(hb + (size_t)t * D + (c * 64 + lane) * 4) = pk4(v[0], v[1], v[2], v[3]);
                }
#pragma unroll
                for (int o = 32; o > 0; o >>= 1) ss += __shfl_xor(ss, o);
                if (lane == 0) rstd[t] = 1.0f / sqrtf(ss * (1.0f / D) + EPS);
            } else {
#pragma unroll
                for (int c = 0; c < 4; ++c) *(u32x2*)(hb + (size_t)t * D + (c * 64 + lane) * 4) = (u32x2){0u, 0u};
                if (lane == 0) rstd[t] = 0.f;
            }
        }
    }
    {
        float* ldsf = (float*)(smem + LDS_MISC);
        const int nw = (gridDim.x == 256) ? W_EARLY : W_ALL;
        for (int id = bid; id < nw; id += nblk) weight_tile(p, id, ldsf, tid);
    }
}

template <int MODE>
DI void phase1(const Params& p, unsigned char* smem, int tid) {
    unsigned char* ws = p.ws;
    unsigned char* ob = (unsigned char*)p.out;
    const bf16_t* hb = (const bf16_t*)(ws + OFF_HB);
    const bf16_t* wt1 = (const bf16_t*)(ws + OFF_WT1);
    const float* rstd = (const float*)(ws + OFF_RSTD0);
    unsigned char* lds = smem + LDS_MISC;
    const int xcd = blockIdx.x & 7, cu = blockIdx.x >> 3, per_round = gridDim.x;
    for (int rb = 0; rb < 14 * 65; rb += per_round) {
        const int idp = rb + xcd * (per_round >> 3) + cu;
        if (idp >= 14 * 65) {
            if (gridDim.x == 256) {
                constexpr int NIDLE = 4 * 256 - 14 * 65;
                int ti = tid; asm volatile("" : "+v"(ti));
                for (int id = W_EARLY + (idp - 14 * 65); id < W_ALL; id += NIDLE) weight_tile(p, id, (float*)lds, ti);
            }
            continue;
        }
        int F, tt;
        if (idp < 16 * 56) { const int g = idp / 56, rem = idp - g * 56; F = rem >> 2; tt = g * 4 + (rem & 3); }
        else { F = idp - 16 * 56; tt = 64; }
        f32x16 acc[4][2];
        if (F < 9 || F == 13) {
            const int rowbase = F * 256;
            int tl = tid; asm volatile("" : "+v"(tl));
            gemm_tile3r<4, 4, MODE>(wt1 + (size_t)rowbase * 1024, 1024, hb + (size_t)tt * 256 * 1024, 1024, 1024, lds, acc, tl);
            int te = tid; asm volatile("" : "+v"(te));
            const int lane = te & 63, wid = te >> 6, wi = wid >> 2, wj = wid & 3, h = lane >> 5, ln = lane & 31;
            if (F < 9) {
                float rsj[2];
#pragma unroll
                for (int jt = 0; jt < 2; ++jt) rsj[jt] = rstd[tt * 256 + wj * 64 + jt * 32 + ln] * ((F >= 1 && F <= 4) ? FOX_QS : 1.0f);
                bf16_t* dbase = F == 0 ? (bf16_t*)(ob + OUT_CQ) : F <= 4 ? (bf16_t*)(ws + OFF_FQ) + (F - 1) * 256 : (bf16_t*)(ws + OFF_FK) + (F - 5) * 256;
                const int dld = F == 0 ? 256 : 1024;
                if (F == 0) {
#pragma unroll
                    for (int jt = 0; jt < 2; ++jt) {
                        float sq = 0.f;
#pragma unroll
                        for (int it = 0; it < 4; ++it)
#pragma unroll
                            for (int r = 0; r < 16; ++r) { const float v = acc[it][jt][r] * rsj[jt]; sq += v * v; }
                        { const auto sw = __builtin_amdgcn_permlane32_swap(__float_as_uint(sq), __float_as_uint(sq), false, false);
                          sq = __uint_as_float(sw[0]) + __uint_as_float(sw[1]); }
                        if (h == 0) atomicAdd((float*)(ws + OFF_SSQC) + tt * 256 + wj * 64 + jt * 32 + ln, sq);
                    }
                }
                staged_rows<4, 4>(lds, te,
                    [&](int it, int jt, int g) { const float sc = rsj[jt]; return pk4(acc[it][jt][4 * g] * sc, acc[it][jt][4 * g + 1] * sc, acc[it][jt][4 * g + 2] * sc, acc[it][jt][4 * g + 3] * sc); },
                    [&](int row, int col, u32x4 v) { __builtin_nontemporal_store(v, (u32x4*)(dbase + (size_t)(tt * 256 + row) * dld + col)); });
                continue;
            }
#pragma unroll
            for (int jt = 0; jt < 2; ++jt) {
                const int t = tt * 256 + wj * 64 + jt * 32 + ln;
                const float rs = rstd[t];
                if (wi == 0) {
                    float sq = 0.f;
#pragma unroll
                    for (int it = 0; it < 4; ++it)
#pragma unroll
                        for (int r = 0; r < 16; ++r) { const float v = acc[it][jt][r] * rs; sq += v * v; }
                    { const auto sw = __builtin_amdgcn_permlane32_swap(__float_as_uint(sq), __float_as_uint(sq), false, false);
                      sq = __uint_as_float(sw[0]) + __uint_as_float(sw[1]); }
                    if (h == 0) ((float*)(ws + OFF_RKV))[t] = 1.0f / sqrtf(sq * (1.0f / 128) + EPS);
                }
#pragma unroll
                for (int it = 0; it < 4; ++it) {
                    const int fb = rowbase + wi * 128 + it * 32;
                    if (fb < 3456) {
                        bf16_t* dst; float sc = rs;
                        if (fb < 256) dst = (bf16_t*)(ob + OUT_CQ) + (size_t)t * 256 + fb;
                        else if (fb < 1280) { dst = (bf16_t*)(ws + OFF_FQ) + (size_t)t * 1024 + (fb - 256); sc = rs * FOX_QS; }
                        else if (fb < 2304) dst = (bf16_t*)(ws + OFF_FK) + (size_t)t * 1024 + (fb - 1280);
                        else dst = (bf16_t*)(ob + OUT_CKV) + (size_t)t * 128 + (fb - 3328);
#pragma unroll
                        for (int g = 0; g < 4; ++g)
                            *(u32x2*)(dst + 8 * g + 4 * h) = pk4(acc[it][jt][4 * g] * sc, acc[it][jt][4 * g + 1] * sc, acc[it][jt][4 * g + 2] * sc, acc[it][jt][4 * g + 3] * sc);
                    } else if (fb == 3456) {
                        float* dst = (float*)(ob + OUT_KPE) + (size_t)t * 32;
#pragma unroll
                        for (int g = 0; g < 4; ++g)
                            *(f32x4*)(dst + 8 * g + 4 * h) = (f32x4){acc[it][jt][4 * g] * rs, acc[it][jt][4 * g + 1] * rs, acc[it][jt][4 * g + 2] * rs, acc[it][jt][4 * g + 3] * rs};
                    } else if (fb == 3488) {
                        float* dst = (float*)(ws + OFF_FLOGIT) + (size_t)t * 16;
#pragma unroll
                        for (int g = 0; g < 2; ++g)
                            *(f32x4*)(dst + 8 * g + 4 * h) = (f32x4){acc[it][jt][4 * g] * rs, acc[it][jt][4 * g + 1] * rs, acc[it][jt][4 * g + 2] * rs, acc[it][jt][4 * g + 3] * rs};
                    }
                }
            }
        } else {
            const int fn = F - 9;
            int tl = tid; asm volatile("" : "+v"(tl));
            gemm_tile3r<4, 4, MODE>(hb + (size_t)tt * 256 * 1024, 1024, wt1 + (size_t)(2304 + fn * 256) * 1024, 1024, 1024, lds, acc, tl);
            int te = tid; asm volatile("" : "+v"(te));
            const int lane = te & 63, wid = te >> 6, wi = wid >> 2, h = lane >> 5; (void)lane;
            bf16_t* fvt = (bf16_t*)(ws + OFF_FVT);
            staged_rows<4, 4>(lds, te,
                [&](int it, int jt, int g) { const f32x4 rs = *(const f32x4*)(rstd + tt * 256 + wi * 128 + it * 32 + 8 * g + 4 * h);
                    return pk4(acc[it][jt][4 * g] * rs[0], acc[it][jt][4 * g + 1] * rs[1], acc[it][jt][4 * g + 2] * rs[2], acc[it][jt][4 * g + 3] * rs[3]); },
                [&](int row, int col, u32x4 v) { const int feat = fn * 256 + row, t = tt * 256 + col;
                    if (t < T) { const int b = t / L, l = t - b * L; __builtin_nontemporal_store(v, (u32x4*)(fvt + ((size_t)(b * NH + (feat >> 6)) * 64 + (feat & 63)) * LP + l)); } });
        }
    }
}

DI float log_sigmoid(float x) { return fminf(x, 0.f) - log1pf(__expf(-fabsf(x))); }

DI void phase2(const Params& p, unsigned char* smem, int tid) {
    unsigned char* ws = p.ws;
    unsigned char* ob = (unsigned char*)p.out;
    unsigned char* lds = smem + LDS_MISC;
    float* lrs = (float*)smem;
    const bf16_t* cq = (const bf16_t*)(ob + OUT_CQ);
    const bf16_t* ckv = (const bf16_t*)(ob + OUT_CKV);
    const float* rope = (const float*)(ws + OFF_ROPE);
    constexpr int U_SCAN = 64, U_Q = U_SCAN + 6 * 65, U_KN = U_Q + 4 * 65, U_V = U_KN + 4 * 65, U_KPE = U_V + 130, U_KMAX = U_KPE + 129;
    const int tid_in = tid;
    for (int id = blockIdx.x; id < U_KMAX; id += gridDim.x) {
        __syncthreads();
        int tid = tid_in; asm volatile("" : "+v"(tid));
        const int lane = tid & 63, wid = tid >> 6; (void)lane; (void)wid;
        if (id < U_SCAN) {
            const int b = id >> 4, hd = id & 15;
            const float fb = p.fox_b[hd];
            const float* fl = (const float*)(ws + OFF_FLOGIT) + (size_t)b * L * 16 + hd;
            float* wsum = (float*)smem;
            const int l0 = tid * 9;
            float v[9];
#pragma unroll
            for (int i = 0; i < 9; ++i) { const int l = l0 + i; v[i] = (l < L) ? fl[(size_t)l * 16] : 0.f; }
            float run = 0.f;
#pragma unroll
            for (int i = 0; i < 9; ++i) { const int l = l0 + i; run += (l < L) ? log_sigmoid(v[i] + fb) : 0.f; v[i] = run; }
            float inc = run;
#pragma unroll
            for (int o = 1; o < 64; o <<= 1) { const float u = __shfl_up(inc, o); if (lane >= o) inc += u; }
            if (lane == 63) wsum[wid] = inc;
            __syncthreads();
            float base = inc - run;
            for (int w = 0; w < wid; ++w) base += wsum[w];
            float* bias = (float*)(ws + OFF_BIAS) + (size_t)(b * NH + hd) * LP;
#pragma unroll
            for (int i = 0; i < 9; ++i) { const int l = l0 + i; if (l < LP) bias[l] = (l < L) ? -(base + v[i]) * LOG2E : 0.f; }
            __syncthreads();
        } else if (id < U_Q) {
            const int j = id - U_SCAN, f = j / 65, tt = j - f * 65;
            f32x16 acc[4][2];
            { int tl = tid; asm volatile("" : "+v"(tl));
              gemm_tile2<4, 4>((const bf16_t*)(ws + OFF_WUQ) + (size_t)f * 256 * 256, 256, cq + (size_t)tt * 256 * 256, 256, 256, lds, acc, tl); }
            int te = tid; asm volatile("" : "+v"(te));
            const int lane = te & 63, wid = te >> 6, wi = wid >> 2, wj = wid & 3, h = lane >> 5, ln = lane & 31; (void)wi; (void)wj; (void)h; (void)ln;
#pragma unroll
            for (int jt = 0; jt < 2; ++jt) {
                const int tl = wj * 64 + jt * 32 + ln, t = tt * 256 + tl;
                const float rq = MLA_QS / sqrtf(((const float*)(ws + OFF_SSQC))[t] * (1.0f / 256) + EPS);
                const int pos = t % L;
#pragma unroll
                for (int it = 0; it < 4; ++it) {
                    const int blk = (f * 256 + wi * 128 + it * 32) >> 5, hd = blk / 3, part = blk - hd * 3;
                    if (part < 2) {
#pragma unroll
                        for (int r = 0; r < 16; ++r) acc[it][jt][r] *= rq;
                    } else {
                        const float* rp = rope + (size_t)pos * 32;
#pragma unroll
                        for (int g = 0; g < 2; ++g) {
                            const f32x4 c4 = *(const f32x4*)(rp + 8 * g + 4 * h), s4 = *(const f32x4*)(rp + 16 + 8 * g + 4 * h);
#pragma unroll
                            for (int e = 0; e < 4; ++e) {
                                const float x1 = acc[it][jt][4 * g + e] * rq, x2 = acc[it][jt][4 * g + e + 8] * rq;
                                acc[it][jt][4 * g + e] = x1 * c4[e] - x2 * s4[e]; acc[it][jt][4 * g + e + 8] = x1 * s4[e] + x2 * c4[e];
                            }
                        }
                    }
                }
            }
            {
                bf16_t* qn = (bf16_t*)(ws + OFF_QN); bf16_t* qpe = (bf16_t*)(ws + OFF_QPE);
                staged_rows<4, 4>(lds, te,
                    [&](int it, int jt, int g) { return pk4(acc[it][jt][4 * g], acc[it][jt][4 * g + 1], acc[it][jt][4 * g + 2], acc[it][jt][4 * g + 3]); },
                    [&](int row, int col, u32x4 v) { const int t = tt * 256 + row, ff = f * 256 + col, blk = ff >> 5, hd = blk / 3, part = blk - hd * 3;
                        bf16_t* d = part < 2 ? qn + (size_t)t * 1024 + hd * 64 + part * 32 + (ff & 31) : qpe + (size_t)t * 512 + hd * 32 + (ff & 31);
                        *(u32x4*)d = v; });
            }
        } else if (id < U_KN) {
            const int j = id - U_Q, f = j / 65, tt = j - f * 65;
            f32x16 acc[4][2];
            { int tl = tid; asm volatile("" : "+v"(tl));
              gemm_tile2<4, 4>((const bf16_t*)(ws + OFF_WUKV) + (size_t)f * 256 * 128, 128, ckv + (size_t)tt * 256 * 128, 128, 128, lds, acc, tl); }
            int te = tid; asm volatile("" : "+v"(te));
            const int lane = te & 63, wid = te >> 6, wi = wid >> 2, wj = wid & 3, h = lane >> 5, ln = lane & 31; (void)wi; (void)wj; (void)h; (void)ln;
            {
                float rk[2];
#pragma unroll
                for (int jt = 0; jt < 2; ++jt) rk[jt] = ((const float*)(ws + OFF_RKV))[tt * 256 + wj * 64 + jt * 32 + ln];
                bf16_t* km = (bf16_t*)(ob + OUT_KM);
                staged_rows<4, 4>(lds, te,
                    [&](int it, int jt, int g) { const float sc = rk[jt]; return pk4(acc[it][jt][4 * g] * sc, acc[it][jt][4 * g + 1] * sc, acc[it][jt][4 * g + 2] * sc, acc[it][jt][4 * g + 3] * sc); },
                    [&](int row, int col, u32x4 v) { const int t = tt * 256 + row, ff = f * 256 + col;
                        *(u32x4*)(km + (size_t)t * 1536 + (ff >> 6) * 96 + (ff & 63)) = v; });
            }
        } else if (id < U_V) {
            const int j = id - U_KN, fn = j / 65, tt = j - fn * 65;
            f32x16 acc[4][2];
            { int tl = tid; asm volatile("" : "+v"(tl));
              gemm_tile2<4, 4>(ckv + (size_t)tt * 256 * 128, 128, (const bf16_t*)(ws + OFF_WUKV) + (size_t)(1024 + fn * 256) * 128, 128, 128, lds, acc, tl); }
            int te = tid; asm volatile("" : "+v"(te));
            const int lane = te & 63, wid = te >> 6, wi = wid >> 2, wj = wid & 3, h = lane >> 5, ln = lane & 31; (void)wi; (void)wj; (void)h; (void)ln;
            bf16_t* vmt = (bf16_t*)(ws + OFF_VMT);
            staged_rows<4, 4>(lds, te,
                [&](int it, int jt, int g) { const f32x4 rs = *(const f32x4*)((const float*)(ws + OFF_RKV) + tt * 256 + wi * 128 + it * 32 + 8 * g + 4 * h);
                    return pk4(acc[it][jt][4 * g] * rs[0], acc[it][jt][4 * g + 1] * rs[1], acc[it][jt][4 * g + 2] * rs[2], acc[it][jt][4 * g + 3] * rs[3]); },
                [&](int row, int col, u32x4 v) { const int feat = fn * 256 + row, t = tt * 256 + col;
                    if (t < T) { const int b = t / L, l = t - b * L; *(u32x4*)(vmt + ((size_t)(b * NH + (feat >> 6)) * 64 + (feat & 63)) * LP + l) = v; } });
        } else if (id >= U_KPE) {
            const int row = (id - U_KPE) * 128 + (tid >> 2), q = tid & 3;
            float v[4] = {0.f, 0.f, 0.f, 0.f};
            if (row < T) {
                const bf16_t* kp = (const bf16_t*)(ws + OFF_FK) + (size_t)row * 1024 + q * 256;
#pragma unroll
                for (int hh = 0; hh < 4; ++hh)
#pragma unroll
                    for (int c = 0; c < 8; ++c) {
                        const u32x4 w = *(const u32x4*)(kp + hh * 64 + c * 8);
#pragma unroll
                        for (int e = 0; e < 4; ++e) { const float a = bf_lo(w[e]), b2 = bf_hi(w[e]); v[hh] += a * a + b2 * b2; }
                    }
            }
#pragma unroll
            for (int hh = 0; hh < 4; ++hh) {
#pragma unroll
                for (int o = 4; o < 64; o <<= 1) v[hh] = fmaxf(v[hh], __shfl_xor(v[hh], o));
            }
            const int row0 = (id - U_KPE) * 128 + wid * 16;
            if (lane < 4 && row0 < T) {
                unsigned* km2 = (unsigned*)(ws + OFF_CTRL) + 64 + (row0 / L) * NH + lane * 4;
#pragma unroll
                for (int hh = 0; hh < 4; ++hh) atomicMax(km2 + hh, __float_as_uint(v[hh]));
            }
        } else {
            const int item = (id - U_V) * NT + tid;
            const int t = item >> 2, q = item & 3;
            const int pos = t % L;
            const float* kp = (const float*)(ob + OUT_KPE) + (size_t)t * 32 + q * 4;
            const f32x4 x1 = *(const f32x4*)kp, x2 = *(const f32x4*)(kp + 16);
            const f32x4 c4 = *(const f32x4*)(rope + (size_t)pos * 32 + q * 4), s4 = *(const f32x4*)(rope + (size_t)pos * 32 + 16 + q * 4);
            const u32x2 y1 = pk4(x1[0] * c4[0] - x2[0] * s4[0], x1[1] * c4[1] - x2[1] * s4[1], x1[2] * c4[2] - x2[2] * s4[2], x1[3] * c4[3] - x2[3] * s4[3]);
            const u32x2 y2 = pk4(x1[0] * s4[0] + x2[0] * c4[0], x1[1] * s4[1] + x2[1] * c4[1], x1[2] * s4[2] + x2[2] * c4[2], x1[3] * s4[3] + x2[3] * c4[3]);
            bf16_t* dst = (bf16_t*)(ob + OUT_KM) + (size_t)t * 1536 + 64 + q * 4;
#pragma unroll
            for (int hd = 0; hd < NH; ++hd) { *(u32x2*)(dst + hd * 96) = y1; *(u32x2*)(dst + hd * 96 + 16) = y2; }
        }
    }
}

template <int DK, bool FOX>
DI void attn_unit(const bf16_t* qa, int ldqa, const bf16_t* qb, int ldqb,
                  const bf16_t* kbase, int ldk,
                  const bf16_t* vt,
                  const float* bias,
                  bf16_t* obase, int ldo,
                  int qi, unsigned char* lds, int tid, float kmax2 = 0.f, int* flags = nullptr) {
    constexpr int KS = DK / 16, KROW = DK * 2 + 16, VROW = 136;
    constexpr int KBYTES = 64 * KROW, VBYTES = 64 * VROW, STG = KBYTES + VBYTES + 256;
    constexpr int KCH = DK / 8;
    constexpr int NKC = 64 * KCH / NT;
    const int lane = tid & 63, wid = tid >> 6, h = lane >> 5, ln = lane & 31;
    const int q0 = NMETA + 256 * qi;
    const int qw0 = q0 + 32 * wid;
    const int myq = qw0 + ln;
    const int nkt = (q0 + 255) / 64 + 1;
    bf16x8 qf[KS];
#pragma unroll
    for (int ks = 0; ks < KS; ++ks) {
        if (ks < 4) qf[ks] = *(const bf16x8*)(qa + (size_t)myq * ldqa + ks * 16 + h * 8);
        else qf[ks] = *(const bf16x8*)(qb + (size_t)myq * ldqb + (ks - 4) * 16 + h * 8);
    }
    f32x16 o[2];
#pragma unroll
    for (int d = 0; d < 2; ++d)
#pragma unroll
        for (int r = 0; r < 16; ++r) o[d][r] = 0.f;
    float m = -INFINITY, lsum = 0.f;
    float qkb = 0.f; bool wdone = false;
    if (FOX) {
        float q2 = 0.f;
#pragma unroll
        for (int ks = 0; ks < 4; ++ks) {
            const u32x4 w = __builtin_bit_cast(u32x4, qf[ks]);
#pragma unroll
            for (int e = 0; e < 4; ++e) { const float a = bf_lo(w[e]), b2 = bf_hi(w[e]); q2 += a * a + b2 * b2; }
        }
        { const auto sw = __builtin_amdgcn_permlane32_swap(__float_as_uint(q2), __float_as_uint(q2), false, false);
          q2 = __uint_as_float(sw[0]) + __uint_as_float(sw[1]); }
        qkb = sqrtf(q2 * kmax2) * 1.01f + 0.01f;
    }
    constexpr int NK2 = (64 * KCH + NT - 1) / NT;
    u32x4 kr[NK2]; u32x4 vr; float br = 0.f;
    auto gload = [&](int j) {
#pragma unroll
        for (int r = 0; r < NK2; ++r) {
            const int c = tid + NT * r;
            if (c < 64 * KCH) { const int row = c / KCH, ch = c - row * KCH; kr[r] = *(const u32x4*)(kbase + (size_t)(64 * j + row) * ldk + ch * 8); }
        }
        { const int row = tid >> 3, ch = tid & 7; vr = *(const u32x4*)(vt + (size_t)row * LP + 64 * j + ch * 8); }
        if (FOX) { if (tid < 64) br = bias[64 * j + tid]; }
    };
    auto lstore = [&](int st) {
        unsigned char* base = lds + st * STG;
#pragma unroll
        for (int r = 0; r < NK2; ++r) {
            const int c = tid + NT * r;
            if (c < 64 * KCH) { const int row = c / KCH, ch = c - row * KCH; *(u32x4*)(base + row * KROW + ch * 16) = kr[r]; }
        }
        { const int row = tid >> 3, ch = tid & 7; unsigned char* d = base + KBYTES + row * VROW + ch * 16;
          *(u32x2*)d = (u32x2){vr[0], vr[1]}; *(u32x2*)(d + 8) = (u32x2){vr[2], vr[3]}; }
        if (FOX) { if (tid < 64) *(float*)(base + KBYTES + VBYTES + tid * 4) = br; }
    };
    const int jlast = nkt - 1;
    gload(jlast); lstore(0);
    __syncthreads();
    m = -1e30f;
#pragma unroll 1
    for (int itn = 0; itn < nkt; ++itn) {
        const int j = jlast - itn;
        const int st = itn & 1;
        if (j > 0) gload(j - 1);
        if (FOX && !wdone && 64 * j <= qw0 + 31) {
            const float bmax = *(const float*)(lds + st * STG + KBYTES + VBYTES + 63 * 4);
            const bool need = !((m > -1e29f) && (qkb + bmax < m - 40.0f));
            if (__builtin_amdgcn_ballot_w64(need) == 0ull) wdone = true;
        }
        if (!wdone && 64 * j <= qw0 + 31) {
            const unsigned char* kb = lds + st * STG;
            const unsigned char* vb = kb + KBYTES;
            f32x16 s[2];
            if (FOX) {
                const float* bl = (const float*)(vb + VBYTES);
#pragma unroll
                for (int t2 = 0; t2 < 2; ++t2)
#pragma unroll
                    for (int g = 0; g < 4; ++g) {
                        const f32x4 b4 = *(const f32x4*)(bl + t2 * 32 + 8 * g + 4 * h);
                        s[t2][4 * g] = b4[0]; s[t2][4 * g + 1] = b4[1]; s[t2][4 * g + 2] = b4[2]; s[t2][4 * g + 3] = b4[3];
                    }
            } else {
#pragma unroll
                for (int t2 = 0; t2 < 2; ++t2)
#pragma unroll
                    for (int r = 0; r < 16; ++r) s[t2][r] = 0.f;
            }
            bf16x8 kf[KS][2];
#pragma unroll
            for (int ks = 0; ks < KS; ++ks)
#pragma unroll
                for (int t2 = 0; t2 < 2; ++t2) kf[ks][t2] = *(const bf16x8*)(kb + (t2 * 32 + ln) * KROW + ks * 32 + h * 16);
            __builtin_amdgcn_sched_barrier(0);
#pragma unroll
            for (int ks = 0; ks < KS; ++ks)
#pragma unroll
                for (int t2 = 0; t2 < 2; ++t2) s[t2] = __builtin_amdgcn_mfma_f32_32x32x16_bf16(kf[ks][t2], qf[ks], s[t2], 0, 0, 0);
            __builtin_amdgcn_sched_barrier(0);
            u32x2 vf[4][2][2];
#pragma unroll
            for (int kk = 0; kk < 4; ++kk)
#pragma unroll
                for (int d = 0; d < 2; ++d) {
                    const unsigned char* va = vb + (d * 32 + ln) * VROW + (16 * kk + 4 * h) * 2;
                    vf[kk][d][0] = *(const u32x2*)va; vf[kk][d][1] = *(const u32x2*)(va + 16);
                }
            __builtin_amdgcn_sched_barrier(0);
            if (64 * j + 63 > qw0) {
                const int thr = myq - 64 * j - 4 * h;
#pragma unroll
                for (int t2 = 0; t2 < 2; ++t2)
#pragma unroll
                    for (int r = 0; r < 16; ++r) { if (((r & 3) + 8 * (r >> 2) + 32 * t2) > thr) s[t2][r] = -INFINITY; }
            }
            float mxa[2];
#pragma unroll
            for (int t2 = 0; t2 < 2; ++t2) {
                float x0 = fmaxf(fmaxf(s[t2][0], s[t2][1]), s[t2][2]);
                float x1 = fmaxf(fmaxf(s[t2][3], s[t2][4]), s[t2][5]);
                float x2 = fmaxf(fmaxf(s[t2][6], s[t2][7]), s[t2][8]);
                float x3 = fmaxf(fmaxf(s[t2][9], s[t2][10]), s[t2][11]);
                float x4 = fmaxf(fmaxf(s[t2][12], s[t2][13]), s[t2][14]);
                mxa[t2] = fmaxf(fmaxf(fmaxf(x0, x1), x2), fmaxf(fmaxf(x3, x4), s[t2][15]));
            }
            float mx = fmaxf(mxa[0], mxa[1]);
            { const auto sw = __builtin_amdgcn_permlane32_swap(__float_as_uint(mx), __float_as_uint(mx), false, false);
              mx = fmaxf(__uint_as_float(sw[0]), __uint_as_float(sw[1])); }
            if (__builtin_amdgcn_ballot_w64(mx > m + 8.0f) != 0ull) {
                const float mn = fmaxf(m, mx);
                const float alpha = __builtin_amdgcn_exp2f(m - mn);
                m = mn;
                lsum *= alpha;
#pragma unroll
                for (int d = 0; d < 2; ++d)
#pragma unroll
                    for (int r = 0; r < 16; ++r) o[d][r] *= alpha;
            }
            float ps0 = 0.f, ps1 = 0.f, ps2 = 0.f, ps3 = 0.f;
#pragma unroll
            for (int t2 = 0; t2 < 2; ++t2)
#pragma unroll
                for (int r = 0; r < 16; r += 4) {
                    const float e0 = __builtin_amdgcn_exp2f(s[t2][r] - m), e1 = __builtin_amdgcn_exp2f(s[t2][r + 1] - m);
                    const float e2 = __builtin_amdgcn_exp2f(s[t2][r + 2] - m), e3 = __builtin_amdgcn_exp2f(s[t2][r + 3] - m);
                    s[t2][r] = e0; s[t2][r + 1] = e1; s[t2][r + 2] = e2; s[t2][r + 3] = e3;
                    ps0 += e0; ps1 += e1; ps2 += e2; ps3 += e3;
                }
            lsum += (ps0 + ps1) + (ps2 + ps3);
#pragma unroll
            for (int kk = 0; kk < 4; ++kk) {
                const int t2 = kk >> 1, s8 = (kk & 1) * 8;
                u32x4 pw;
                pw[0] = pk2(s[t2][s8 + 0], s[t2][s8 + 1]); pw[1] = pk2(s[t2][s8 + 2], s[t2][s8 + 3]);
                pw[2] = pk2(s[t2][s8 + 4], s[t2][s8 + 5]); pw[3] = pk2(s[t2][s8 + 6], s[t2][s8 + 7]);
                const bf16x8 pf = __builtin_bit_cast(bf16x8, pw);
#pragma unroll
                for (int d = 0; d < 2; ++d) {
                    const u32x4 vw = {vf[kk][d][0][0], vf[kk][d][0][1], vf[kk][d][1][0], vf[kk][d][1][1]};
                    o[d] = __builtin_amdgcn_mfma_f32_32x32x16_bf16(__builtin_bit_cast(bf16x8, vw), pf, o[d], 0, 0, 0);
                }
            }
        }
        if (j > 0) lstore(st ^ 1);
        if (FOX) {
            if (lane == 0) flags[(itn & 1) * 8 + wid] = wdone ? 1 : 0;
            __syncthreads();
            const u32x4 f0 = *(const u32x4*)(flags + (itn & 1) * 8), f1 = *(const u32x4*)(flags + (itn & 1) * 8 + 4);
            if ((f0[0] & f0[1] & f0[2] & f0[3] & f1[0] & f1[1] & f1[2] & f1[3]) != 0u) break;
        } else {
            __syncthreads();
        }
    }
    if (FOX) __syncthreads();
    { const auto sw = __builtin_amdgcn_permlane32_swap(__float_as_uint(lsum), __float_as_uint(lsum), false, false);
      lsum = __uint_as_float(sw[0]) + __uint_as_float(sw[1]); }
    const float inv = 1.0f / lsum;
    {
        unsigned char* sb = lds + 2 * STG + wid * (32 * 144);
#pragma unroll
        for (int d = 0; d < 2; ++d)
#pragma unroll
            for (int g = 0; g < 4; ++g)
                *(u32x2*)(sb + ln * 144 + (d * 32 + 8 * g + 4 * h) * 2) = pk4(o[d][4 * g] * inv, o[d][4 * g + 1] * inv, o[d][4 * g + 2] * inv, o[d][4 * g + 3] * inv);
        __builtin_amdgcn_fence(__ATOMIC_RELEASE, "wavefront");
        __builtin_amdgcn_wave_barrier();
        __builtin_amdgcn_fence(__ATOMIC_ACQUIRE, "wavefront");
#pragma unroll
        for (int ps = 0; ps < 4; ++ps) {
            const int row = ps * 8 + (lane >> 3), ch = lane & 7;
            const u32x4 v = *(const u32x4*)(sb + row * 144 + ch * 16);
            *(u32x4*)(obase + (size_t)(qw0 + row) * ldo + ch * 8) = v;
        }
    }
}

DI void phase3(const Params& p, unsigned char* smem, int tid, int cidx) {
    unsigned char* ws = p.ws;
    unsigned char* ob = (unsigned char*)p.out;
    unsigned char* lds = smem + LDS_MISC;
    unsigned* ctr = (unsigned*)(ws + OFF_CTRL) + cidx;
    int* sh = (int*)smem;
    int* flags = (int*)(smem + 1056);
    const float* kmax2 = (const float*)(ws + OFF_CTRL) + 64;
    if (gridDim.x == 256) {
        const int xcd = blockIdx.x & 7, cu = blockIdx.x >> 3, s4 = (cu >> 3) & 3, j8 = cu & 7;
        for (int r = 0; r < 2; ++r) {
            const int bh = (r * 4 + s4) * 8 + xcd, b = bh >> 4, hd = bh & 15;
            const size_t t0 = (size_t)b * L;
            for (int half = 0; half < 2; ++half) {
                const int qi = half == 0 ? 15 - j8 : j8;
                bf16_t* qn = (bf16_t*)(ws + OFF_QN) + t0 * 1024 + hd * 64;
                attn_unit<96, false>(qn, 1024, (const bf16_t*)(ws + OFF_QPE) + t0 * 512 + hd * 32, 512,
                                     (const bf16_t*)(ob + OUT_KM) + t0 * 1536 + hd * 96, 1536,
                                     (const bf16_t*)(ws + OFF_VMT) + (size_t)(b * NH + hd) * 64 * LP, nullptr, qn, 1024, qi, lds, tid);
            }
        }
    }
    const int nun = (gridDim.x == 256) ? 1024 : 2048;
    for (;;) {
        if (tid == 0) sh[0] = (int)atomicAdd(ctr, 1u);
        __syncthreads();
        const int u = sh[0];
        __syncthreads();
        if (u >= nun) break;
        int qi, type, bh;
        if (gridDim.x == 256) { qi = 15 - (u >> 6); bh = u & 63; type = 1; }
        else { qi = 15 - (u >> 7); const int rem = u & 127; type = rem & 1; bh = rem >> 1; }
        const int b = bh >> 4, hd = bh & 15;
        const size_t t0 = (size_t)b * L;
        if (type == 0) {
            bf16_t* qn = (bf16_t*)(ws + OFF_QN) + t0 * 1024 + hd * 64;
            attn_unit<96, false>(qn, 1024, (const bf16_t*)(ws + OFF_QPE) + t0 * 512 + hd * 32, 512,
                                 (const bf16_t*)(ob + OUT_KM) + t0 * 1536 + hd * 96, 1536,
                                 (const bf16_t*)(ws + OFF_VMT) + (size_t)(b * NH + hd) * 64 * LP, nullptr, qn, 1024, qi, lds, tid);
        } else {
            bf16_t* fq = (bf16_t*)(ws + OFF_FQ) + t0 * 1024 + hd * 64;
            attn_unit<64, true>(fq, 1024, fq, 1024, (const bf16_t*)(ws + OFF_FK) + t0 * 1024 + hd * 64, 1024,
                                (const bf16_t*)(ws + OFF_FVT) + (size_t)(b * NH + hd) * 64 * LP,
                                (const float*)(ws + OFF_BIAS) + (size_t)(b * NH + hd) * LP, fq, 1024, qi, lds, tid, kmax2[b * NH + hd], flags);
        }
    }
}

DI int real_tile_row(int tt) { return (tt >> 5) * L + NMETA + (tt & 31) * 128; }

DI int real_tile_row256(int tt) { return (tt >> 4) * L + NMETA + (tt & 15) * 256; }
constexpr size_t OFF_G = OFF_FVT;
static_assert((size_t)8 * 64 * 256 * 256 * 2 <= 2 * (size_t)NB * NH * 64 * LP * 2, "gate buffer too large");
DI void phase3b(const Params& p, unsigned char* smem, int tid) {
    unsigned char* ws = p.ws;
    const bf16_t* hb = (const bf16_t*)(ws + OFF_HB);
    const float* rstd = (const float*)(ws + OFF_RSTD0);
    unsigned char* lds = smem + LDS_MISC;
    const int xcd = blockIdx.x & 7, cu = blockIdx.x >> 3, per_round = gridDim.x;
    auto tile_ptrs = [&](int rb, const bf16_t*& P, const bf16_t*& Q) __attribute__((always_inline)) -> bool {
        const int idp = rb + xcd * (per_round >> 3) + cu;
        if (rb >= 16 * 64 || idp >= 16 * 64) return false;
        const int half = idp >> 9, i9 = idp & 511, f = (i9 & 31) >> 2, tt = (i9 >> 5) * 4 + (i9 & 3);
        P = (const bf16_t*)(ws + (half == 0 ? OFF_WZ : OFF_WG)) + (size_t)f * 256 * 1024;
        Q = hb + (size_t)real_tile_row256(tt) * 1024;
        return true;
    };
    GSets gs;
    const bf16_t* Pn = nullptr; const bf16_t* Qn = nullptr;
    bool vn = tile_ptrs(0, Pn, Qn);
    if (vn) { int ti = tid; asm volatile("" : "+v"(ti)); gemm_issue(Pn, Qn, gs, ti); }
    for (int rb = 0; rb < 16 * 64; rb += per_round) {
        const int idp = rb + xcd * (per_round >> 3) + cu;
        const bool v = vn;
        const bf16_t* P = Pn; const bf16_t* Q = Qn;
        if (!v) { vn = tile_ptrs(rb + per_round, Pn, Qn); if (vn) { int ti = tid; asm volatile("" : "+v"(ti)); gemm_issue(Pn, Qn, gs, ti); } continue; }
        const int half = idp >> 9, i9 = idp & 511;
        const int f = (i9 & 31) >> 2, tt = (i9 >> 5) * 4 + (i9 & 3);
        const int r0 = real_tile_row256(tt);
        f32x16 acc[4][2];
        { int tl = tid; asm volatile("" : "+v"(tl));
          gemm_tile3p<4, 4>(P, 1024, Q, 1024, lds, acc, tl, gs); }
        vn = tile_ptrs(rb + per_round, Pn, Qn);
        if (vn) { int ti = tid; asm volatile("" : "+v"(ti)); gemm_issue(Pn, Qn, gs, ti); }
        int te = tid; asm volatile("" : "+v"(te));
        const int lane = te & 63, wid = te >> 6, wj = wid & 3, ln = lane & 31;
        float rsj[2];
#pragma unroll
        for (int jt = 0; jt < 2; ++jt) rsj[jt] = rstd[r0 + wj * 64 + jt * 32 + ln];
        if (half == 0) {
            bf16_t* obuf = (bf16_t*)(ws + (f < 4 ? OFF_QN : OFF_FQ)) + (f & 3) * 256;
            staged_rows_rmw<4, 4>(lds, te,
                [&](int it, int jt, int g) { const float sc = rsj[jt];
                    return pk4(fsilu(acc[it][jt][4 * g] * sc), fsilu(acc[it][jt][4 * g + 1] * sc), fsilu(acc[it][jt][4 * g + 2] * sc), fsilu(acc[it][jt][4 * g + 3] * sc)); },
                [&](int row, int col) { return *(const u32x4*)(obuf + (size_t)(r0 + row) * 1024 + col); },
                [&](int row, int col, u32x4 v, u32x4 o) { u32x4 w;
#pragma unroll
                    for (int e = 0; e < 4; ++e) w[e] = pk2(bf_lo(o[e]) * bf_lo(v[e]), bf_hi(o[e]) * bf_hi(v[e]));
                    *(u32x4*)(obuf + (size_t)(r0 + row) * 1024 + col) = w; });
        } else {
            unsigned char* gt = ws + OFF_G + ((size_t)(f * 64 + tt) * 8 + wid) * 16384 + lane * 16;
#pragma unroll
            for (int it = 0; it < 4; ++it)
#pragma unroll
                for (int jt = 0; jt < 2; ++jt)
#pragma unroll
                    for (int gp = 0; gp < 2; ++gp) {
                        const float sc = rsj[jt];
                        u32x4 w;
#pragma unroll
                        for (int e = 0; e < 4; ++e) w[e] = pk2(fsigmoid(acc[it][jt][8 * gp + 2 * e] * sc), fsigmoid(acc[it][jt][8 * gp + 2 * e + 1] * sc));
                        *(u32x4*)(gt + ((it * 2 + jt) * 2 + gp) * 1024) = w;
                    }
        }
    }
}

DI void phase4(const Params& p, unsigned char* smem, int tid) {
    unsigned char* ws = p.ws;
    unsigned char* lds = smem + LDS_MISC;
    bf16_t* mx = (bf16_t*)(ws + OFF_FK);
    const int xcd = blockIdx.x & 7, cu = blockIdx.x >> 3, per_round = gridDim.x;
    for (int rb = 0; rb < 4 * 64; rb += per_round) {
        const int idp = rb + xcd * (per_round >> 3) + cu;
        if (idp >= 4 * 64) continue;
        const int f = (idp & 31) >> 3, tt = (idp >> 5) * 8 + (idp & 7);
        const int r0 = real_tile_row256(tt);
        f32x16 acc[4][2];
        { int tl = tid; asm volatile("" : "+v"(tl));
          gemm_tile3r<4, 4>((const bf16_t*)(ws + OFF_WBM) + (size_t)f * 256 * 1024, 1024, (const bf16_t*)(ws + OFF_QN) + (size_t)r0 * 1024, 1024, 1024, lds, acc, tl); }
        {
            int te = tid; asm volatile("" : "+v"(te));
            const unsigned char* ga = ws + OFF_G + ((size_t)(f * 64 + tt) * 8 + (te >> 6)) * 16384 + (te & 63) * 16;
            const unsigned char* gb = ga + (size_t)4 * 64 * 8 * 16384;
#pragma unroll
            for (int it = 0; it < 4; ++it)
#pragma unroll
                for (int jt = 0; jt < 2; ++jt)
#pragma unroll
                    for (int gp = 0; gp < 2; ++gp) {
                        const u32x4 a4 = *(const u32x4*)(ga + ((it * 2 + jt) * 2 + gp) * 1024), b4 = *(const u32x4*)(gb + ((it * 2 + jt) * 2 + gp) * 1024);
#pragma unroll
                        for (int e = 0; e < 4; ++e) {
                            acc[it][jt][8 * gp + 2 * e] *= bf_lo(a4[e]) * __builtin_amdgcn_rcpf(fmaxf(bf_lo(b4[e]), 8.6736174e-19f));
                            acc[it][jt][8 * gp + 2 * e + 1] *= bf_hi(a4[e]) * __builtin_amdgcn_rcpf(fmaxf(bf_hi(b4[e]), 8.6736174e-19f));
                        }
                    }
        }
        { int tl = tid; asm volatile("" : "+v"(tl));
          gemm_tile3r<4, 4, 0, false>((const bf16_t*)(ws + OFF_WBF) + (size_t)f * 256 * 1024, 1024, (const bf16_t*)(ws + OFF_FQ) + (size_t)r0 * 1024, 1024, 1024, lds, acc, tl); }
        {
            int te = tid; asm volatile("" : "+v"(te));
            const unsigned char* gb = ws + OFF_G + ((size_t)((4 + f) * 64 + tt) * 8 + (te >> 6)) * 16384 + (te & 63) * 16;
            staged_rows<4, 4>(lds, te,
                [&](int it, int jt, int g) { const u32x4 b4 = *(const u32x4*)(gb + ((it * 2 + jt) * 2 + (g >> 1)) * 1024); const int e0 = (g & 1) * 2;
                    const float g0 = fmaxf(bf_lo(b4[e0]), 8.6736174e-19f), g1 = fmaxf(bf_hi(b4[e0]), 8.6736174e-19f);
                    const float g2 = fmaxf(bf_lo(b4[e0 + 1]), 8.6736174e-19f), g3 = fmaxf(bf_hi(b4[e0 + 1]), 8.6736174e-19f);
                    return pk4(acc[it][jt][4 * g] * g0, acc[it][jt][4 * g + 1] * g1, acc[it][jt][4 * g + 2] * g2, acc[it][jt][4 * g + 3] * g3); },
                [&](int row, int col, u32x4 v) { *(u32x4*)(mx + (size_t)(r0 + row) * 1024 + f * 256 + col) = v; });
        }
    }
}

DI void phase5(const Params& p, unsigned char* smem, int tid, bool coop) {
    unsigned char* ws = p.ws;
    unsigned char* lds = smem + LDS_MISC;
    const bf16_t* mx = (const bf16_t*)(ws + OFF_FK);
    float* ssq = (float*)(ws + OFF_SSQ);
    const bool fused = coop && gridDim.x == 256;
    const int xcd = blockIdx.x & 7, cu = blockIdx.x >> 3, per_round = gridDim.x;
    for (int rb = 0; rb < 4 * 64; rb += per_round) {
        const int idp = rb + xcd * (per_round >> 3) + cu;
        if (idp >= 4 * 64) continue;
        const int f = (idp & 31) >> 3, tt = (idp >> 5) * 8 + (idp & 7);
        const int r0 = real_tile_row256(tt);
        f32x16 acc[4][2];
        int tl = tid; asm volatile("" : "+v"(tl));
        gemm_tile3r<4, 4>((const bf16_t*)(ws + OFF_WOUT) + (size_t)f * 256 * 1024, 1024, mx + (size_t)r0 * 1024, 1024, 1024, lds, acc, tl);
        int te = tid; asm volatile("" : "+v"(te));
        const int lane = te & 63, wid = te >> 6, wi = wid >> 2, wj = wid & 3, h = lane >> 5, ln = lane & 31;
#pragma unroll
        for (int jt = 0; jt < 2; ++jt) {
            const int tr = tt * 256 + wj * 64 + jt * 32 + ln;
            float sq = 0.f;
#pragma unroll
            for (int it = 0; it < 4; ++it)
#pragma unroll
                for (int r = 0; r < 16; ++r) sq += acc[it][jt][r] * acc[it][jt][r];
            { const auto sw = __builtin_amdgcn_permlane32_swap(__float_as_uint(sq), __float_as_uint(sq), false, false);
              sq = __uint_as_float(sw[0]) + __uint_as_float(sw[1]); }
            if (h == 0) atomicAdd(ssq + tr, sq);
        }
        if (fused) {
            unsigned* cnt = (unsigned*)(ws + OFF_CTRL) + 128 + tt;
            unsigned* bar = (unsigned*)(ws + OFF_BAR);
            asm volatile("s_waitcnt vmcnt(0)" ::: "memory");
            __syncthreads();
            if (te == 0) {
                __builtin_amdgcn_fence(__ATOMIC_RELEASE, "agent");
                (void)xb_add(cnt, 1u);
                XB_SPIN(xb_ld(cnt) < 4u, bar);
                __builtin_amdgcn_fence(__ATOMIC_ACQUIRE, "agent");
            }
            __syncthreads();
            float rsj[2];
#pragma unroll
            for (int jt = 0; jt < 2; ++jt)
                rsj[jt] = 1.0f / sqrtf(__hip_atomic_load(ssq + tt * 256 + wj * 64 + jt * 32 + ln, __ATOMIC_RELAXED, __HIP_MEMORY_SCOPE_AGENT) * (1.0f / D) + EPS);
            staged_rows_rmw<4, 4>(lds, te,
                [&](int it, int jt, int g) { const f32x4 gv = *(const f32x4*)(p.post_g + f * 256 + wi * 128 + it * 32 + 8 * g + 4 * h); const float rs = rsj[jt];
                    return pk4(acc[it][jt][4 * g] * rs * gv[0], acc[it][jt][4 * g + 1] * rs * gv[1], acc[it][jt][4 * g + 2] * rs * gv[2], acc[it][jt][4 * g + 3] * rs * gv[3]); },
                [&](int row, int col) { const size_t o = (size_t)(tt * 256 + row) * 1024 + f * 256 + col; X8 r; r.a = __builtin_nontemporal_load((const f32x4*)(p.x + o)); r.b = __builtin_nontemporal_load((const f32x4*)(p.x + o + 4)); return r; },
                [&](int row, int col, u32x4 v, X8 xv) { const size_t o = (size_t)(tt * 256 + row) * 1024 + f * 256 + col;
                    __builtin_nontemporal_store((f32x4){xv.a[0] + bf_lo(v[0]), xv.a[1] + bf_hi(v[0]), xv.a[2] + bf_lo(v[1]), xv.a[3] + bf_hi(v[1])}, (f32x4*)(p.out + o));
                    __builtin_nontemporal_store((f32x4){xv.b[0] + bf_lo(v[2]), xv.b[1] + bf_hi(v[2]), xv.b[2] + bf_lo(v[3]), xv.b[3] + bf_hi(v[3])}, (f32x4*)(p.out + o + 4)); });
        } else {
#pragma unroll
            for (int jt = 0; jt < 2; ++jt) {
                const int tr = tt * 256 + wj * 64 + jt * 32 + ln;
#pragma unroll
                for (int it = 0; it < 4; ++it) {
                    float* dst = p.out + (size_t)tr * 1024 + f * 256 + wi * 128 + it * 32;
#pragma unroll
                    for (int g = 0; g < 4; ++g)
                        *(f32x4*)(dst + 8 * g + 4 * h) = (f32x4){acc[it][jt][4 * g], acc[it][jt][4 * g + 1], acc[it][jt][4 * g + 2], acc[it][jt][4 * g + 3]};
                }
            }
        }
    }
}

DI void phase6(const Params& p, int tid) {
    const float* ssq = (const float*)(p.ws + OFF_SSQ);
    const int gsz = gridDim.x * NT;
    for (int i = blockIdx.x * NT + tid; i < NB * S * (D / 4); i += gsz) {
        const int tr = i >> 8, c = (i & 255) * 4;
        const float rs = 1.0f / sqrtf(ssq[tr] * (1.0f / D) + EPS);
        const f32x4 mv = *(const f32x4*)(p.out + (size_t)i * 4);
        const f32x4 xv = *(const f32x4*)(p.x + (size_t)i * 4);
        const f32x4 g = *(const f32x4*)(p.post_g + c);
        *(f32x4*)(p.out + (size_t)i * 4) = (f32x4){xv[0] + mv[0] * rs * g[0], xv[1] + mv[1] * rs * g[1], xv[2] + mv[2] * rs * g[2], xv[3] + mv[3] * rs * g[3]};
    }
}

template <bool COOP>
__global__ void __launch_bounds__(NT) mega(Params p, int lo, int hi) {
    extern __shared__ __attribute__((aligned(16))) unsigned char smem[];
    const int wave_s = __builtin_amdgcn_readfirstlane((int)threadIdx.x >> 6);
#define TID0 ([&]() __attribute__((always_inline)) { unsigned z_ = 0u; asm volatile("" : "+s"(z_)); return (wave_s << 6) | (int)__builtin_amdgcn_mbcnt_hi(~0u, __builtin_amdgcn_mbcnt_lo(~0u, z_)); }())
    volatile LAS unsigned* xst = (volatile LAS unsigned*)(smem + 1024);
    XcdBarrier xb; xb.bar = (unsigned*)(p.ws + OFF_BAR); xb.x = 0u; xb.st = xst;
    if (COOP) {
        if (hi < lo) cg::this_grid().sync();
        { const int t0_ = TID0; if (t0_ < 4) xst[t0_] = 0u; }
        __syncthreads();
        xb = xcd_barrier_post((unsigned*)(p.ws + OFF_BAR), xst);
    }
#define SEAM(n) if (COOP && (n) < hi) { xcd_barrier(xb); }
#define PHASE(n, call) if (lo <= (n) && (n) <= hi) { int tid = TID0; asm volatile("" : "+v"(tid)); call; SEAM(n) }
    PHASE(0, phase0(p, smem, tid))
#if PROBE_DUP & 1
    PHASE(0, phase0(p, smem, tid))
#endif
#if PROBE_DUP & 64
    if (COOP) { for (int i_ = 0; i_ < 10; ++i_) xcd_barrier(xb); }
#endif
#if PROBE_DUP & 2
    PHASE(1, phase1<PROBE_MODE>(p, smem, tid))
#endif
    PHASE(1, phase1<0>(p, smem, tid))
    PHASE(2, phase2(p, smem, tid))
#if PROBE_DUP & 4
    PHASE(2, phase2(p, smem, tid))
#endif
    PHASE(3, phase3(p, smem, tid, 0))
#if PROBE_DUP & 8
    PHASE(1, phase1<0>(p, smem, tid))
    PHASE(2, phase2(p, smem, tid))
    PHASE(3, phase3(p, smem, tid, 1))
#endif
    PHASE(4, phase3b(p, smem, tid))
    PHASE(5, phase4(p, smem, tid))
#if PROBE_DUP & 32
    PHASE(5, phase4(p, smem, tid))
#endif
    if (lo <= 6 && 6 <= hi) { int tid = TID0; asm volatile("" : "+v"(tid)); phase5(p, smem, tid, COOP); if (COOP && 6 < hi && gridDim.x != 256) xcd_barrier(xb); }
    if (lo <= 7 && 7 <= hi && (!COOP || gridDim.x != 256)) { int tid = TID0; asm volatile("" : "+v"(tid)); phase6(p, tid); }
#undef PHASE
#undef SEAM
}

extern "C" void kernel_launch(void* const* d_in, const int* in_sizes, int n_in, void* d_out, int out_size, void* d_ws, size_t ws_size,
                              hipStream_t stream) {
    static int grid = 0;
    if (grid == 0) {
        if (n_in != 13 || out_size != NB * S * D || ws_size < WS_END) {
            fprintf(stderr, "kernel_launch: unexpected shapes: n_in %d out %d ws %zu (need %zu)\n", n_in, out_size, ws_size, (size_t)WS_END);
            grid = -1; return;
        }
        int dev = 0, cus = 0, per_cu = 0;
        (void)hipGetDevice(&dev);
        (void)hipDeviceGetAttribute(&cus, hipDeviceAttributeMultiprocessorCount, dev);
#if MK_LAUNCHES == 1
        const void* fn = (const void*)mega<true>;
#else
        const void* fn = (const void*)mega<false>;
#endif
        if (hipFuncSetAttribute(fn, hipFuncAttributeMaxDynamicSharedMemorySize, LDS_BYTES) != hipSuccess) { fprintf(stderr, "kernel_launch: hipFuncSetAttribute failed\n"); grid = -1; return; }
        if (hipOccupancyMaxActiveBlocksPerMultiprocessor(&per_cu, fn, NT, LDS_BYTES) != hipSuccess || per_cu < 1) { fprintf(stderr, "kernel_launch: occupancy query failed (%d)\n", per_cu); grid = -1; return; }
        grid = cus * 1;
    }
    if (grid < 0) return;
    Params p{};
    p.x = (const float*)d_in[0]; p.meta = (const float*)d_in[1]; p.pre_g = (const float*)d_in[2]; p.w_in = (const float*)d_in[3];
    p.fox_b = (const float*)d_in[4]; p.qn_g = (const float*)d_in[5]; p.kvn_g = (const float*)d_in[6]; p.w_uq = (const float*)d_in[7];
    p.w_ukv = (const float*)d_in[8]; p.w_bm = (const float*)d_in[9]; p.w_bf = (const float*)d_in[10]; p.w_out = (const float*)d_in[11];
    p.post_g = (const float*)d_in[12];
    p.out = (float*)d_out; p.ws = (unsigned char*)d_ws;
#if MK_LAUNCHES == 1
    if (hipMemsetAsync((unsigned char*)d_ws + OFF_BAR, 0, XCD_BAR_WORDS * 4, stream) != hipSuccess) { fprintf(stderr, "kernel_launch: memset of the barrier words failed\n"); return; }
    int lo = 0, hi = 7;
    void* args[] = {&p, &lo, &hi};
    hipError_t e = hipLaunchCooperativeKernel((const void*)mega<true>, dim3(grid), dim3(NT), args, LDS_BYTES, stream);
    if (e != hipSuccess) fprintf(stderr, "cooperative launch failed: %s (grid %d)\n", hipGetErrorString(e), grid);
#else
    for (int ph = 0; ph <= 7; ++ph) hipLaunchKernelGGL(mega<false>, dim3(grid), dim3(NT), LDS_BYTES, stream, p, ph, ph);
#endif
}
```
